# Optimizing an MI355X kernel written in HIP

```python
import jax, jax.numpy as jnp
from jax import lax
import numpy as np

D_MODEL = 1024
BATCH = 2
SEQ = 16384
DEPTH = 4

CHUNK = 64
CONV_CH = 512
CONV_WIDTH = 3
GLA_HEADS = 4
GLA_DK = 64
GLA_DV = 128
GLA_KW = GLA_HEADS * GLA_DK
GLA_VW = GLA_HEADS * GLA_DV
GATE_RANK = 16
GATE_NORMALIZER = 16.0
GATE_LOG_MIN = -1.0
MIX_WIDTH = CONV_CH + GLA_VW
IN_WIDTH = 3 * CONV_CH + 2 * GLA_KW + 2 * GLA_VW + GATE_RANK
IN_SPLITS = (
    CONV_CH,
    2 * CONV_CH,
    3 * CONV_CH,
    3 * CONV_CH + GLA_KW,
    3 * CONV_CH + 2 * GLA_KW,
    3 * CONV_CH + 2 * GLA_KW + GLA_VW,
    3 * CONV_CH + 2 * GLA_KW + 2 * GLA_VW,
)
D_FF = 2816
N_EXPERTS = 8
TOP_K = 2
D_FF_EXPERT = 2816
N_DENSE = (DEPTH + 1) // 2
N_MOE = DEPTH // 2
DEEPNORM_ALPHA = (2.0 * DEPTH) ** 0.25
DEEPNORM_BETA = (8.0 * DEPTH) ** -0.25
LN_EPS = 1e-5
RMS_EPS = 1e-6

kernel_name = "hybrid_conv_gla_moe_deepnorm_adaln_trunk"


def _layernorm(x, g, b):
    xf = x.astype(jnp.float32)
    mu = jnp.mean(xf, axis=-1, keepdims=True)
    var = jnp.mean(jnp.square(xf - mu), axis=-1, keepdims=True)
    return ((xf - mu) * lax.rsqrt(var + LN_EPS) * g.astype(jnp.float32)
            + b.astype(jnp.float32)).astype(x.dtype)


def _causal_depthwise_conv(z, w):
    return lax.conv_general_dilated(
        z, w[:, None, :].astype(z.dtype), window_strides=(1,),
        padding=[(CONV_WIDTH - 1, 0)],
        dimension_numbers=("NWC", "WIO", "NWC"),
        feature_group_count=z.shape[-1])


def _gla_chunked(q, k, v, gk):
    bsz, seq = q.shape[0], q.shape[1]
    n_chunks = seq // CHUNK
    shp_k = (bsz, n_chunks, CHUNK, GLA_HEADS, GLA_DK)
    shp_v = (bsz, n_chunks, CHUNK, GLA_HEADS, GLA_DV)
    q = q.astype(jnp.float32).reshape(shp_k) * (GLA_DK ** -0.5)
    k = k.astype(jnp.float32).reshape(shp_k)
    v = v.astype(jnp.float32).reshape(shp_v)
    b = jnp.cumsum(gk.astype(jnp.float32).reshape(shp_k), axis=2)
    b_last = b[:, :, -1:]
    q_in = q * jnp.exp(b)
    k_in = k * jnp.exp(-b)
    k_out = k * jnp.exp(b_last - b)
    causal = jnp.tril(jnp.ones((CHUNK, CHUNK), dtype=bool))
    scores = jnp.einsum("bnihd,bnjhd->bnhij", q_in, k_in)
    scores = jnp.where(causal, scores, 0.0)
    o_intra = jnp.einsum("bnhij,bnjhv->bnihv", scores, v)
    kv_chunk = jnp.einsum("bnjhd,bnjhv->bnhdv", k_out, v)
    decay_chunk = jnp.exp(b_last[:, :, 0])

    def step(state, inp):
        kv_n, dec_n = inp
        return dec_n[..., None] * state + kv_n, state

    init = jnp.zeros((bsz, GLA_HEADS, GLA_DK, GLA_DV), jnp.float32)
    _, states = lax.scan(step, init, (jnp.swapaxes(kv_chunk, 0, 1), jnp.swapaxes(decay_chunk, 0, 1)))
    states = jnp.swapaxes(states, 0, 1)
    o_inter = jnp.einsum("bnihd,bnhdv->bnihv", q_in, states)
    return (o_intra + o_inter).reshape(bsz, seq, GLA_HEADS, GLA_DV)


def _mixer(u, w_in, conv_w, gk_w2, gk_b, gla_norm_w, w_out):
    bsz, seq, _ = u.shape
    proj = jnp.einsum("bsd,de->bse", u, w_in)
    c_b, c_c, c_h, q, k, v, g, g_low = jnp.split(proj, IN_SPLITS, axis=-1)
    y_conv = c_b * _causal_depthwise_conv(c_c * c_h, conv_w)
    gk = jax.nn.log_sigmoid((jnp.einsum("bsr,rk->bsk", g_low, gk_w2) + gk_b).astype(jnp.float32))
    gk = jnp.maximum(gk / GATE_NORMALIZER, GATE_LOG_MIN)
    o = _gla_chunked(q.reshape(bsz, seq, GLA_HEADS, GLA_DK),
                     k.reshape(bsz, seq, GLA_HEADS, GLA_DK),
                     v.reshape(bsz, seq, GLA_HEADS, GLA_DV),
                     gk.reshape(bsz, seq, GLA_HEADS, GLA_DK))
    o = o * lax.rsqrt(jnp.mean(jnp.square(o), axis=-1, keepdims=True) + RMS_EPS)
    o = o * gla_norm_w.astype(jnp.float32) * jax.nn.silu(
        g.astype(jnp.float32).reshape(bsz, seq, GLA_HEADS, GLA_DV))
    y_gla = o.reshape(bsz, seq, GLA_VW).astype(u.dtype)
    y = jnp.concatenate([y_conv, y_gla], axis=-1)
    return jnp.einsum("bse,ed->bsd", y, w_out)


def _dense_swiglu(u, w_gate, w_up, w_down):
    h = jax.nn.silu(jnp.einsum("bsd,df->bsf", u, w_gate)) * jnp.einsum("bsd,df->bsf", u, w_up)
    return jnp.einsum("bsf,fd->bsd", h, w_down)


def _moe_swiglu(u, w_router, w_gate, w_up, w_down):
    bsz, seq, dm = u.shape
    n_tok = bsz * seq
    xt = u.reshape(n_tok, dm)
    logits = jnp.dot(xt, w_router).astype(jnp.float32)
    top_logits, top_idx = lax.top_k(logits, TOP_K)
    top_w = jax.nn.softmax(top_logits, axis=-1).astype(u.dtype)
    flat_e = top_idx.reshape(-1)
    order = jnp.argsort(flat_e)
    tok = order // TOP_K
    group_sizes = jnp.bincount(flat_e, length=N_EXPERTS).astype(jnp.int32)
    xs = xt[tok]
    h = jax.nn.silu(lax.ragged_dot(xs, w_gate, group_sizes)) * lax.ragged_dot(xs, w_up, group_sizes)
    ys = lax.ragged_dot(h, w_down, group_sizes) * top_w.reshape(-1)[order][:, None]
    out = jax.ops.segment_sum(ys, tok, num_segments=n_tok)
    return out.reshape(bsz, seq, dm)


def setup_inputs(seed: int = 0) -> dict:
    key = jax.random.key(seed)
    ks = jax.random.split(key, 24)
    nrm = jax.random.normal
    f32 = jnp.float32
    x = nrm(ks[0], (BATCH, SEQ, D_MODEL), f32)
    c = nrm(ks[1], (BATCH, D_MODEL), f32)
    ada_w = nrm(ks[2], (DEPTH, D_MODEL, 6 * D_MODEL), f32) * (0.1 * D_MODEL ** -0.5)
    ada_b = nrm(ks[3], (DEPTH, 6 * D_MODEL), f32) * 0.02
    w_in = nrm(ks[4], (DEPTH, D_MODEL, IN_WIDTH), f32) * D_MODEL ** -0.5
    conv_w = nrm(ks[5], (DEPTH, CONV_WIDTH, CONV_CH), f32) * CONV_WIDTH ** -0.5
    gk_w2 = nrm(ks[6], (DEPTH, GATE_RANK, GLA_KW), f32) * GATE_RANK ** -0.5
    gk_b = nrm(ks[7], (DEPTH, GLA_KW), f32) * 0.02
    gla_norm_w = 1.0 + 0.02 * nrm(ks[8], (DEPTH, GLA_DV), f32)
    w_out = nrm(ks[9], (DEPTH, MIX_WIDTH, D_MODEL), f32) * (DEEPNORM_BETA * MIX_WIDTH ** -0.5)
    ln1_g = 1.0 + 0.02 * nrm(ks[10], (DEPTH, D_MODEL), f32)
    ln1_b = 0.02 * nrm(ks[11], (DEPTH, D_MODEL), f32)
    ln2_g = 1.0 + 0.02 * nrm(ks[12], (DEPTH, D_MODEL), f32)
    ln2_b = 0.02 * nrm(ks[13], (DEPTH, D_MODEL), f32)
    ffn_w_gate = nrm(ks[14], (N_DENSE, D_MODEL, D_FF), f32) * D_MODEL ** -0.5
    ffn_w_up = nrm(ks[15], (N_DENSE, D_MODEL, D_FF), f32) * D_MODEL ** -0.5
    ffn_w_down = nrm(ks[16], (N_DENSE, D_FF, D_MODEL), f32) * (DEEPNORM_BETA * D_FF ** -0.5)
    router_w = nrm(ks[17], (N_MOE, D_MODEL, N_EXPERTS), f32) * D_MODEL ** -0.5
    moe_w_gate = nrm(ks[18], (N_MOE, N_EXPERTS, D_MODEL, D_FF_EXPERT), f32) * D_MODEL ** -0.5
    moe_w_up = nrm(ks[19], (N_MOE, N_EXPERTS, D_MODEL, D_FF_EXPERT), f32) * D_MODEL ** -0.5
    moe_w_down = nrm(ks[20], (N_MOE, N_EXPERTS, D_FF_EXPERT, D_MODEL), f32) * (DEEPNORM_BETA * D_FF_EXPERT ** -0.5)
    return {"x": x, "c": c, "ada_w": ada_w, "ada_b": ada_b, "w_in": w_in, "conv_w": conv_w,
            "gk_w2": gk_w2, "gk_b": gk_b, "gla_norm_w": gla_norm_w, "w_out": w_out,
            "ln1_g": ln1_g, "ln1_b": ln1_b, "ln2_g": ln2_g, "ln2_b": ln2_b,
            "ffn_w_gate": ffn_w_gate, "ffn_w_up": ffn_w_up, "ffn_w_down": ffn_w_down,
            "router_w": router_w, "moe_w_gate": moe_w_gate, "moe_w_up": moe_w_up,
            "moe_w_down": moe_w_down}


def reference(x, c, ada_w, ada_b, w_in, conv_w, gk_w2, gk_b, gla_norm_w, w_out,
              ln1_g, ln1_b, ln2_g, ln2_b, ffn_w_gate, ffn_w_up, ffn_w_down,
              router_w, moe_w_gate, moe_w_up, moe_w_down):
    cond = jax.nn.silu(c)
    for layer in range(DEPTH):
        mod = (jnp.dot(cond, ada_w[layer]) + ada_b[layer])[:, None, :]
        sh1, sc1, g1, sh2, sc2, g2 = jnp.split(mod, 6, axis=-1)
        u = x * (1.0 + sc1) + sh1
        mix = _mixer(u, w_in[layer], conv_w[layer], gk_w2[layer], gk_b[layer],
                     gla_norm_w[layer], w_out[layer])
        x = _layernorm(DEEPNORM_ALPHA * x + (1.0 + g1) * mix, ln1_g[layer], ln1_b[layer])
        u = x * (1.0 + sc2) + sh2
        j = layer // 2
        if layer % 2 == 0:
            ff = _dense_swiglu(u, ffn_w_gate[j], ffn_w_up[j], ffn_w_down[j])
        else:
            ff = _moe_swiglu(u, router_w[j], moe_w_gate[j], moe_w_up[j], moe_w_down[j])
        x = _layernorm(DEEPNORM_ALPHA * x + (1.0 + g2) * ff, ln2_g[layer], ln2_b[layer])
    return x
```

```cpp
#include <hip/hip_runtime.h>
#include <cstdio>
#include <cstdint>

#ifndef MK_MULTI
#define MK_MULTI 0
#endif

namespace pg8 {
#define PG8_LAS __attribute__((address_space(3)))
typedef unsigned short bf16_t;
typedef short bf16x8 __attribute__((ext_vector_type(8)));
typedef float f32x4 __attribute__((ext_vector_type(4)));
typedef unsigned u32x4 __attribute__((ext_vector_type(4)));
constexpr int BM = 256, BK = 64, HALF = 128, HTB = HALF * BK * 2  , STAGE_BYTES = 8 * HTB, NXCD = 8, WGM = 8;

__host__ __device__ __forceinline__ int lds_byte(int r, int c) { const int st = (r >> 4) * 2 + (c >> 5), rr = r & 15, cc = c & 31, ob = rr * 64 + cc * 2; return st * 1024 + (ob ^ (((ob >> 9) & 1) << 5)); }
__host__ __device__ __forceinline__ void stage_rc(int b, int& R, int& C) { const int st = b / 1024, sb = b % 1024, swz = sb ^ (((sb >> 9) & 1) << 5); R = (st >> 1) * 16 + swz / 64; C = (st & 1) * 32 + (swz % 64) / 2; }
__host__ __device__ __forceinline__ int perm32(int rho) { const int n = rho >> 4, i = rho & 15; return 8 * (i >> 2) + 4 * n + (i & 3); }

struct Unit { int pm, pn; };
struct Gemm { const bf16_t* A; const bf16_t* Bt; int M, N, K; };

struct StaticOrder {
    int nM, nN, nwg, G, c;
    __host__ __device__ void init(int M, int N, int G_, int c_) { nM = M / BM; nN = N / BM; nwg = nM * nN; G = G_; c = c_; }
    __host__ __device__ bool next(int i, Unit& u) const {
        const long L = (long)i * G + c; if (L >= nwg) return false;
        int wgid = (int)L; { const int q = nwg / NXCD, r = nwg % NXCD, xcd = wgid % NXCD, off = wgid / NXCD; wgid = (xcd < r ? xcd * (q + 1) : r * (q + 1) + (xcd - r) * q) + off; }
        const int nig = WGM * nN, gid = wgid / nig, fm = gid * WGM, gsz = (nM - fm) < WGM ? (nM - fm) : WGM;
        u.pm = fm + ((wgid % nig) % gsz); u.pn = (wgid % nig) / gsz; return true;
    }
    __device__ __forceinline__ const char* b_tile(const Gemm& g, const Unit& u) const { return (const char*)g.Bt + (size_t)u.pn * BM * g.K * 2; }
    __device__ __forceinline__ void a_ready(const Unit&) const {}
    __device__ __forceinline__ void done(const Unit&) const {}
};
struct MoeOrder : StaticOrder {
    const int* tile_e;
    __device__ __forceinline__ const char* b_tile(const Gemm& g, const Unit& u) const {
        const int e = __builtin_amdgcn_readfirstlane(tile_e[u.pm]);
        return (const char*)g.Bt + ((size_t)e * g.N + (size_t)u.pn * BM) * g.K * 2; }
};

__device__ __forceinline__ unsigned cvt_pk_bf16(float lo, float hi) { unsigned r; asm volatile("v_cvt_pk_bf16_f32 %0, %1, %2" : "=v"(r) : "v"(lo), "v"(hi)); return r; }

struct EpiBf16 {
    static constexpr bool PERM = true, AFTER_DRAIN = false;
    bf16_t* O; int ldc;
    __device__ __forceinline__ void operator()(const f32x4 (&acc)[2][2][4][2], const Unit& u, int wr, int wc, int fr, int fq) const {
        const int row0 = u.pm * BM + wr * 64 + fr, col0 = u.pn * BM + wc * 32 + 8 * fq;
#pragma unroll
        for (int ai = 0; ai < 2; ++ai)
#pragma unroll
            for (int m = 0; m < 4; ++m) { bf16_t* rowp = O + (size_t)(row0 + ai * HALF + m * 16) * ldc + col0;
#pragma unroll
                for (int bj = 0; bj < 2; ++bj) { const f32x4 v0 = acc[ai][bj][m][0], v1 = acc[ai][bj][m][1];
                    u32x4 w; w.x = cvt_pk_bf16(v0[0], v0[1]); w.y = cvt_pk_bf16(v0[2], v0[3]); w.z = cvt_pk_bf16(v1[0], v1[1]); w.w = cvt_pk_bf16(v1[2], v1[3]);
                    *(u32x4*)(rowp + bj * HALF) = w; } }
    }
};
__device__ __forceinline__ float silu1(float x) { return x * __builtin_amdgcn_rcpf(1.0f + __builtin_amdgcn_exp2f(-1.44269504089f * x)); }
struct EpiSwiGLU {
    static constexpr bool PERM = true, AFTER_DRAIN = false;
    bf16_t* H; int ldh;
    __device__ __forceinline__ void operator()(const f32x4 (&acc)[2][2][4][2], const Unit& u, int wr, int wc, int fr, int fq) const {
        const int row0 = u.pm * BM + wr * 64 + fr, col0 = u.pn * HALF + wc * 32 + 8 * fq;
#pragma unroll
        for (int ai = 0; ai < 2; ++ai)
#pragma unroll
            for (int m = 0; m < 4; ++m) { bf16_t* rowp = H + (size_t)(row0 + ai * HALF + m * 16) * ldh + col0;
                const f32x4 g0 = acc[ai][0][m][0], g1 = acc[ai][0][m][1], u0 = acc[ai][1][m][0], u1 = acc[ai][1][m][1];
                u32x4 w;
                w.x = cvt_pk_bf16(silu1(g0[0]) * u0[0], silu1(g0[1]) * u0[1]); w.y = cvt_pk_bf16(silu1(g0[2]) * u0[2], silu1(g0[3]) * u0[3]);
                w.z = cvt_pk_bf16(silu1(g1[0]) * u1[0], silu1(g1[1]) * u1[1]); w.w = cvt_pk_bf16(silu1(g1[2]) * u1[2], silu1(g1[3]) * u1[3]);
                *(u32x4*)rowp = w; }
    }
};
struct EpiF32 {
    static constexpr bool PERM = false, AFTER_DRAIN = false;
    float* C; int ldc;
    __device__ __forceinline__ void operator()(const f32x4 (&acc)[2][2][4][2], const Unit& u, int wr, int wc, int fr, int fq) const {
        const int row0 = u.pm * BM + wr * 64 + fr, col0 = u.pn * BM + wc * 32 + 4 * fq;
#pragma unroll
        for (int ai = 0; ai < 2; ++ai)
#pragma unroll
            for (int m = 0; m < 4; ++m) { float* rowp = C + (size_t)(row0 + ai * HALF + m * 16) * ldc + col0;
#pragma unroll
                for (int bj = 0; bj < 2; ++bj)
#pragma unroll
                    for (int n = 0; n < 2; ++n) *(f32x4*)(rowp + bj * HALF + n * 16) = acc[ai][bj][m][n]; }
    }
};
struct EpiMoeDown {
    static constexpr bool PERM = true, AFTER_DRAIN = false;
    bf16_t* Y; int ldc; const int* row_tok; const float* row_w;
    __device__ __forceinline__ void operator()(const f32x4 (&acc)[2][2][4][2], const Unit& u, int wr, int wc, int fr, int fq) const {
        const int row0 = u.pm * BM + wr * 64 + fr, col0 = u.pn * BM + wc * 32 + 8 * fq;
#pragma unroll
        for (int ai = 0; ai < 2; ++ai)
#pragma unroll
            for (int m = 0; m < 4; ++m) { const int r = row0 + ai * HALF + m * 16; const int ts = row_tok[r]; const float w8 = row_w[r];
                if (ts >= 0) { bf16_t* rowp = Y + (size_t)ts * ldc + col0;
#pragma unroll
                    for (int bj = 0; bj < 2; ++bj) { const f32x4 v0 = acc[ai][bj][m][0] * w8, v1 = acc[ai][bj][m][1] * w8;
                        u32x4 w; w.x = cvt_pk_bf16(v0[0], v0[1]); w.y = cvt_pk_bf16(v0[2], v0[3]); w.z = cvt_pk_bf16(v1[0], v1[1]); w.w = cvt_pk_bf16(v1[2], v1[3]);
                        *(u32x4*)(rowp + bj * HALF) = w; } } }
    }
};

template <class Epi, class Sched, bool ALIGN_EPI = false, bool SP2 = false>
__device__ __forceinline__ void gemm_phase(PG8_LAS unsigned char* lds, const Gemm g, const Sched& S, const Epi& E) {
    int tid_ = threadIdx.x; asm volatile("" : "+v"(tid_));
    const int tid = tid_, wid = __builtin_amdgcn_readfirstlane(tid >> 6), lane = tid & 63, wr = wid >> 2, wc = wid & 3, fr = lane & 15, fq = lane >> 4;
    const int K = g.K, nt = K / BK;
    unsigned voffA[2], voffB[2];
#pragma unroll
    for (int i = 0; i < 2; ++i) { int R, C; stage_rc(tid * 16 + i * 8192, R, C); const int Rb = Epi::PERM ? ((R & ~31) + perm32(R & 31)) : R;
        voffA[i] = (unsigned)(R * K + C) * 2u; voffB[i] = (unsigned)(Rb * K + C) * 2u; }
    const size_t kstep = (size_t)(BK * 2);
    const size_t hstep = (size_t)HALF * K * 2;
    const size_t tstep = 2 * hstep;
    const unsigned ldsw = (unsigned)wid * 1024u;
    const int aoff = lds_byte(wr * 64 + fr, fq * 8), boff = lds_byte(wc * 32 + fr, fq * 8);
#define PG8_SA(b, h) (((b) * 2 + (h)) * HTB)
#define PG8_SB(b, h) ((4 + (b) * 2 + (h)) * HTB)
#define PG8_STAGE(bufoff, gbase, voff) do { _Pragma("unroll") for (int _i = 0; _i < 2; ++_i) \
        __builtin_amdgcn_global_load_lds((const unsigned*)((const char*)(gbase) + (voff)[_i]), (PG8_LAS unsigned*)(lds + (bufoff) + ldsw + _i * 8192), 16, 0, 0); } while (0)
#define PG8_LDA(dst, b, h) do { _Pragma("unroll") for (int m = 0; m < 4; ++m) _Pragma("unroll") for (int k = 0; k < 2; ++k) dst[m][k] = *(const PG8_LAS bf16x8*)(lds + PG8_SA(b, h) + aoff + m * 2048 + k * 1024); } while (0)
#define PG8_LDB(dst, b, h) do { _Pragma("unroll") for (int n = 0; n < 2; ++n) _Pragma("unroll") for (int k = 0; k < 2; ++k) dst[n][k] = *(const PG8_LAS bf16x8*)(lds + PG8_SB(b, h) + boff + n * 2048 + k * 1024); } while (0)
#define PG8_MMA(ai, bj, At, Bt) do { __builtin_amdgcn_s_setprio(1); _Pragma("unroll") for (int m = 0; m < 4; ++m) _Pragma("unroll") for (int n = 0; n < 2; ++n) _Pragma("unroll") for (int k = 0; k < 2; ++k) \
        acc[ai][bj][m][n] = __builtin_amdgcn_mfma_f32_16x16x32_bf16(Bt[n][k], At[m][k], acc[ai][bj][m][n], 0, 0, 0); __builtin_amdgcn_s_setprio(0); } while (0)
#define PG8_WAIT_V(n) asm volatile("s_waitcnt vmcnt(" #n ")" ::: "memory")
#define PG8_WAIT_L(n) asm volatile("s_waitcnt lgkmcnt(" #n ")" ::: "memory")
#define PG8_BAR __builtin_amdgcn_s_barrier()
#define PG8_SCHED __builtin_amdgcn_sched_barrier(0)
    Unit cur, nxt; int ui = 0;
    if (!S.next(0, cur)) return;
    f32x4 acc[2][2][4][2];
#pragma unroll
    for (int a = 0; a < 2; ++a)
#pragma unroll
        for (int b = 0; b < 2; ++b)
#pragma unroll
            for (int m = 0; m < 4; ++m)
#pragma unroll
                for (int n = 0; n < 2; ++n) acc[a][b][m][n] = (f32x4){0.f, 0.f, 0.f, 0.f};
    bf16x8 At[4][2], B0[2][2], B1[2][2];
    const char* cA = (const char*)g.A + (size_t)cur.pm * tstep; const char* cB = S.b_tile(g, cur);
    S.a_ready(cur);
    if constexpr (SP2) {
        PG8_STAGE(PG8_SB(0, 0), cB, voffB); PG8_STAGE(PG8_SB(0, 1), cB + hstep, voffB); PG8_STAGE(PG8_SA(0, 0), cA, voffA); PG8_STAGE(PG8_SA(0, 1), cA + hstep, voffA);
        if (wr == 1) PG8_BAR;
        PG8_WAIT_V(2); PG8_BAR;
        PG8_STAGE(PG8_SB(1, 0), cB + kstep, voffB); PG8_STAGE(PG8_SA(1, 0), cA + kstep, voffA); PG8_STAGE(PG8_SB(1, 1), cB + hstep + kstep, voffB);
        PG8_WAIT_V(6); PG8_BAR;
    } else {
        PG8_STAGE(PG8_SB(0, 0), cB, voffB); PG8_STAGE(PG8_SA(0, 0), cA, voffA); PG8_STAGE(PG8_SB(0, 1), cB + hstep, voffB); PG8_STAGE(PG8_SA(0, 1), cA + hstep, voffA);
        if (wr == 1) PG8_BAR;
        PG8_WAIT_V(4); PG8_BAR;
        PG8_STAGE(PG8_SB(1, 0), cB + kstep, voffB); PG8_STAGE(PG8_SA(1, 0), cA + kstep, voffA); PG8_STAGE(PG8_SB(1, 1), cB + hstep + kstep, voffB);
        PG8_WAIT_V(6); PG8_BAR;
    }
    for (;;) {
        const bool has_next = S.next(ui + 1, nxt);
        const char* nA = has_next ? (const char*)g.A + (size_t)nxt.pm * tstep : cA; const char* nB = has_next ? S.b_tile(g, nxt) : cB;
        for (int t = 0; t < nt; t += 2) {
            const bool last = (t == nt - 2);
            const char* a1 = cA + (size_t)(t + 1) * kstep;
            const char* a2 = last ? nA : cA + (size_t)(t + 2) * kstep; const char* b2 = last ? nB : cB + (size_t)(t + 2) * kstep;
            const char* a3 = a2 + kstep; const char* b3 = b2 + kstep;
            if (last && has_next) S.a_ready(nxt);
            if constexpr (SP2) {
            PG8_LDB(B0, 0, 0); PG8_LDB(B1, 0, 1); PG8_SCHED; PG8_LDA(At, 0, 0); PG8_STAGE(PG8_SA(1, 1), a1 + hstep, voffA);
            PG8_WAIT_V(8); PG8_WAIT_L(0); PG8_BAR; PG8_MMA(0, 0, At, B0); PG8_MMA(0, 1, At, B1); PG8_BAR; PG8_SCHED;
            PG8_LDA(At, 0, 1); PG8_STAGE(PG8_SB(0, 0), b2, voffB); PG8_STAGE(PG8_SB(0, 1), b2 + hstep, voffB); PG8_STAGE(PG8_SA(0, 0), a2, voffA);
            PG8_WAIT_V(8); PG8_WAIT_L(0); PG8_BAR; PG8_MMA(1, 0, At, B0); PG8_MMA(1, 1, At, B1); PG8_BAR; PG8_SCHED;
            PG8_LDB(B0, 1, 0); PG8_LDB(B1, 1, 1); PG8_SCHED; PG8_LDA(At, 1, 0); PG8_STAGE(PG8_SA(0, 1), a2 + hstep, voffA);
            PG8_WAIT_V(8); PG8_WAIT_L(0); PG8_BAR; PG8_MMA(0, 0, At, B0); PG8_MMA(0, 1, At, B1); PG8_BAR; PG8_SCHED;
            PG8_LDA(At, 1, 1); PG8_STAGE(PG8_SB(1, 0), b3, voffB); PG8_STAGE(PG8_SB(1, 1), b3 + hstep, voffB); PG8_STAGE(PG8_SA(1, 0), a3, voffA);
            PG8_WAIT_V(8); PG8_WAIT_L(0); PG8_BAR; PG8_MMA(1, 0, At, B0); PG8_MMA(1, 1, At, B1); PG8_BAR; PG8_SCHED;
            } else {
            PG8_LDB(B0, 0, 0); PG8_SCHED; PG8_LDA(At, 0, 0); PG8_STAGE(PG8_SA(1, 1), a1 + hstep, voffA);
            PG8_WAIT_L(8); PG8_BAR; PG8_WAIT_L(0); PG8_MMA(0, 0, At, B0); PG8_BAR; PG8_SCHED;
            PG8_LDB(B1, 0, 1); PG8_STAGE(PG8_SB(0, 0), b2, voffB);
            PG8_BAR; PG8_WAIT_L(0); PG8_MMA(0, 1, At, B1); PG8_BAR;
            PG8_LDA(At, 0, 1); PG8_STAGE(PG8_SA(0, 0), a2, voffA);
            PG8_BAR; PG8_WAIT_L(0); PG8_MMA(1, 0, At, B0); PG8_BAR; PG8_SCHED;
            PG8_STAGE(PG8_SB(0, 1), b2 + hstep, voffB);
            PG8_WAIT_V(6); PG8_BAR; PG8_MMA(1, 1, At, B1); PG8_BAR;
            PG8_LDB(B0, 1, 0); PG8_SCHED; PG8_LDA(At, 1, 0); PG8_STAGE(PG8_SA(0, 1), a2 + hstep, voffA);
            PG8_WAIT_L(8); PG8_BAR; PG8_WAIT_L(0); PG8_MMA(0, 0, At, B0); PG8_BAR; PG8_SCHED;
            PG8_LDB(B1, 1, 1); PG8_STAGE(PG8_SB(1, 0), b3, voffB);
            PG8_BAR; PG8_WAIT_L(0); PG8_MMA(0, 1, At, B1); PG8_BAR;
            PG8_LDA(At, 1, 1); PG8_STAGE(PG8_SA(1, 0), a3, voffA);
            PG8_BAR; PG8_WAIT_L(0); PG8_MMA(1, 0, At, B0); PG8_BAR; PG8_SCHED;
            PG8_STAGE(PG8_SB(1, 1), b3 + hstep, voffB);
            PG8_WAIT_V(6); PG8_BAR; PG8_MMA(1, 1, At, B1); PG8_BAR;
            }
        }
        if constexpr (ALIGN_EPI) { if (wr == 0) PG8_BAR; }
        if constexpr (!Epi::AFTER_DRAIN) { E(acc, cur, wr, wc, fr, fq); S.done(cur); }
        if (!has_next) break;
#pragma unroll
        for (int a = 0; a < 2; ++a)
#pragma unroll
            for (int b = 0; b < 2; ++b)
#pragma unroll
                for (int m = 0; m < 4; ++m)
#pragma unroll
                    for (int n = 0; n < 2; ++n) acc[a][b][m][n] = (f32x4){0.f, 0.f, 0.f, 0.f};
        cur = nxt; cA = nA; cB = nB; ++ui;
        if constexpr (ALIGN_EPI) { if (wr == 1) PG8_BAR; }
    }
    PG8_WAIT_V(0);
    if constexpr (!ALIGN_EPI) { if (wr == 0) PG8_BAR; }
    PG8_BAR;
    if constexpr (Epi::AFTER_DRAIN) { E.fused(acc, cur, wr, wc, fr, fq, lds, wid, lane); S.done(cur); }
#undef PG8_SA
#undef PG8_SB
#undef PG8_STAGE
#undef PG8_LDA
#undef PG8_LDB
#undef PG8_MMA
#undef PG8_WAIT_V
#undef PG8_WAIT_L
#undef PG8_BAR
#undef PG8_SCHED
}
}

constexpr int BATCH = 2, SEQ = 16384, D = 1024, T = BATCH * SEQ, DEPTH = 4;
constexpr int NH = 4, DK = 64, DV = 128, RANK = 16;
constexpr int NPROJ_SRC = 3088, NPROJ = 3328;
constexpr int C_B = 0, C_C = 512, C_H = 1024, C_Q = 1536, C_K = 1792, C_V = 2048, C_G = 2560, C_GK = 3072;
constexpr int FF = 2816, NE = 8, NGU = 2 * FF;
constexpr int NCH = SEQ / 64;
constexpr int NUNIT = BATCH * NCH * NH;
constexpr int MOE_ROWS = 2 * T + NE * 256;
constexpr float ALPHA = 1.6817928305074290f;
constexpr float LN_EPS = 1e-5f, RMS_EPS = 1e-6f;
constexpr int NWAVES = 8, NTHR = 512;

constexpr size_t MiB = 1u << 20;
constexpr size_t WS_CTL = 0, CTL_ZERO_BYTES = 1 * MiB;
constexpr size_t WS_MODP = 1 * MiB;
constexpr size_t WS_MOD = 3 * MiB;
constexpr size_t WS_WIN = 4 * MiB;
constexpr size_t WS_WOUT = 30 * MiB;
constexpr size_t WS_WGU = 38 * MiB;
constexpr size_t WS_WDN = 60 * MiB;
constexpr size_t WS_MWGU = 71 * MiB;
constexpr size_t WS_MWDN = 159 * MiB;
constexpr size_t WS_U = 203 * MiB;
constexpr size_t WS_MISC = 267 * MiB;
constexpr size_t WS_R1 = 269 * MiB;
constexpr size_t WS_PROJ = WS_R1;
constexpr size_t WS_KV = WS_R1 + 208 * MiB;
constexpr size_t WS_ST = WS_R1 + 272 * MiB;
constexpr size_t WS_DEC = WS_R1 + 336 * MiB;
constexpr size_t WS_Y = WS_R1 + 337 * MiB;
constexpr size_t WS_MIX = WS_R1 + 401 * MiB;
constexpr size_t WS_H = WS_R1;
constexpr size_t WS_XS = WS_R1 + 363 * MiB;
constexpr size_t WS_YS = WS_XS;
constexpr size_t WS_END = WS_R1 + 529 * MiB;
static_assert(WS_MIX + (size_t)T * D * 4 <= WS_END && WS_XS + (size_t)MOE_ROWS * D * 2 <= WS_MIX + (size_t)T * D * 4 && WS_H + (size_t)MOE_ROWS * FF * 2 <= WS_XS, "ws map");
static_assert(WS_WIN + (size_t)4 * NPROJ * D * 2 <= WS_WOUT && WS_WGU + (size_t)2 * NGU * D * 2 <= WS_WDN && WS_WDN + (size_t)2 * D * FF * 2 <= WS_MWGU && WS_MWGU + (size_t)NE * NGU * D * 2 <= WS_MWDN && WS_MWDN + (size_t)NE * D * FF * 2 <= WS_U, "ws map 2");
constexpr size_t MS_TOKE = 0;
constexpr size_t MS_TOKW = 256 * 1024;
constexpr size_t MS_CNT = 512 * 1024;
constexpr size_t MS_ROWTOK = 528 * 1024;
constexpr size_t MS_ROWW = 800 * 1024;
constexpr size_t MS_TILEE = 1072 * 1024;
constexpr size_t MS_META = 1080 * 1024;
constexpr int CW_BAR = 4096;

constexpr int LDS_BYTES = 147456;
constexpr int MISC_OFF = LDS_BYTES - 128;

#define GAS __attribute__((address_space(1)))
#define LAS __attribute__((address_space(3)))
typedef unsigned short bf16;
typedef unsigned v4u __attribute__((ext_vector_type(4)));
typedef unsigned v2u __attribute__((ext_vector_type(2)));
typedef float f32x4 __attribute__((ext_vector_type(4)));
#define LDS_WAIT() asm volatile("s_waitcnt lgkmcnt(0)" ::: "memory")
__device__ __forceinline__ unsigned f2bf(float f) { unsigned u = __builtin_bit_cast(unsigned, f); return (u + 0x7fffu + ((u >> 16) & 1u)) >> 16; }
__device__ __forceinline__ unsigned pk2(float lo, float hi) { return f2bf(lo) | (f2bf(hi) << 16); }
__device__ __forceinline__ float bf_lo(unsigned w) { return __builtin_bit_cast(float, w << 16); }
__device__ __forceinline__ float bf_hi(unsigned w) { return __builtin_bit_cast(float, w & 0xffff0000u); }
__device__ __forceinline__ float bf1(bf16 h) { return __builtin_bit_cast(float, ((unsigned)h) << 16); }

#define XB_TMO      128
#define XB_XCNT(j)  (256  + 64 * (j))
#define XB_XSUB(j)  (1280 + 64 * (j))
#define XB_XGEN(j)  (2304 + 64 * (j))
#define XB_TOP      3328
#define XB_TOPGEN   3392
#define XCD_BAR_WORDS 3456
#define XB_SPIN_CAP (1u << 18)
__device__ __forceinline__ unsigned xb_ld(unsigned* p)              { return __hip_atomic_load(p, __ATOMIC_RELAXED, __HIP_MEMORY_SCOPE_AGENT); }
__device__ __forceinline__ unsigned xb_add(unsigned* p, unsigned v) { return __hip_atomic_fetch_add(p, v, __ATOMIC_RELAXED, __HIP_MEMORY_SCOPE_AGENT); }
__device__ __forceinline__ unsigned xb_xcc_id() { return (unsigned)__builtin_amdgcn_s_getreg((3 << 11) | 20) & 0xFu; }
#define XB_SPIN(cond, bar) do { unsigned _sp = 0; while (cond) { __builtin_amdgcn_s_sleep(1); \
    if ((++_sp & 255u) == 0u) { if (xb_ld(&(bar)[XB_TMO])) break; if (_sp > XB_SPIN_CAP) { atomicAdd(&(bar)[XB_TMO], 1u); break; } } } } while (0)
struct XcdBarrier { unsigned* bar; unsigned x; volatile LAS unsigned* st; };
__device__ __forceinline__ XcdBarrier xcd_barrier_post(unsigned* bar, volatile LAS unsigned* st) {
    XcdBarrier b; b.bar = bar; b.x = xb_xcc_id(); b.st = st;
    if (threadIdx.x == 0) (void)xb_add(&bar[XB_XCNT(b.x)], 1u);
    return b;
}
__device__ __forceinline__ void xcd_barrier_complete(unsigned* bar, unsigned x, unsigned& nloc, unsigned& nx) {
    const unsigned G = gridDim.x * gridDim.y * gridDim.z;
    unsigned sum, cnt, mine, sp = 0u;
    for (;;) {
        sum = 0u; cnt = 0u; mine = 0u;
#pragma unroll
        for (unsigned j = 0; j < 16; ++j) { const unsigned c = xb_ld(&bar[XB_XCNT(j)]); sum += c; cnt += (c > 0u) ? 1u : 0u; mine = (j == x) ? c : mine; }
        if (sum == G) break;
        __builtin_amdgcn_s_sleep(1);
        if ((++sp & 255u) == 0u) { if (xb_ld(&bar[XB_TMO])) break; if (sp > XB_SPIN_CAP) { atomicAdd(&bar[XB_TMO], 1u); break; } }
    }
    nloc = mine > 0u ? mine : 1u; nx = cnt > 0u ? cnt : 1u;
}
__device__ __forceinline__ void xcd_barrier(const XcdBarrier& b) {
    asm volatile("s_waitcnt vmcnt(0)" ::: "memory");
    __syncthreads();
    if (threadIdx.x == 0) {
        unsigned* bar = b.bar;
        __builtin_amdgcn_s_waitcnt(0);
        unsigned nloc = b.st[0], nx = b.st[1];
        if (nloc == 0u) { xcd_barrier_complete(bar, b.x, nloc, nx); b.st[0] = nloc; b.st[1] = nx; }
        const unsigned old = xb_add(&bar[XB_XSUB(b.x)], 1u);
        const unsigned gen = old / nloc;
        if (old + 1u == (gen + 1u) * nloc) {
            __builtin_amdgcn_fence(__ATOMIC_RELEASE, "agent");
            asm volatile("s_waitcnt vmcnt(0)" ::: "memory");
            const unsigned og = xb_add(&bar[XB_TOP], 1u);
            const unsigned tg = og / nx;
            if (og + 1u == (tg + 1u) * nx) xb_add(&bar[XB_TOPGEN], 1u);
            else XB_SPIN(xb_ld(&bar[XB_TOPGEN]) == tg, bar);
            __builtin_amdgcn_fence(__ATOMIC_ACQUIRE, "agent");
            xb_add(&bar[XB_XGEN(b.x)], 1u);
            asm volatile("s_waitcnt vmcnt(0)" ::: "memory");
        } else {
            XB_SPIN(xb_ld(&bar[XB_XGEN(b.x)]) == gen, bar);
            __builtin_amdgcn_fence(__ATOMIC_ACQUIRE, "agent");
            asm volatile("s_waitcnt vmcnt(0)" ::: "memory");
        }
    }
    __syncthreads();
}

struct Args { const float* in[21]; float* out; unsigned char* ws; int ph_lo, ph_hi, li, pad; };
typedef const Args __attribute__((address_space(4)))* KA;
__device__ __forceinline__ KA kargs() { KA p = (KA)__builtin_amdgcn_kernarg_segment_ptr(); asm volatile("" : "+s"(p)); return p; }
enum { I_X = 0, I_C, I_ADAW, I_ADAB, I_WIN, I_CONVW, I_GKW2, I_GKB, I_NORMW, I_WOUT, I_LN1G, I_LN1B, I_LN2G, I_LN2B, I_FG, I_FU, I_FD, I_RW, I_MG, I_MU, I_MD };

#define OPAQUE_IDS int tid = threadIdx.x; asm volatile("" : "+v"(tid)); int bid = blockIdx.x; asm volatile("" : "+s"(bid)); (void)tid; (void)bid
__device__ __forceinline__ float wave_sum(float v) {
#pragma unroll
    for (int o = 1; o < 64; o <<= 1) v += __shfl_xor(v, o);
    return v;
}
__device__ __forceinline__ float silu_f(float x) { return x / (1.f + __expf(-x)); }

__device__ __forceinline__ void transpose_item(const float* W, int ldw, int K, bf16* WT, int drow0, int k0, int n0, LAS float* scr, int lane) {
#pragma unroll 8
    for (int i = 0; i < 32; ++i) { const int kk = 2 * i + (lane >> 5); scr[kk * 33 + (lane & 31)] = W[(size_t)(k0 + kk) * ldw + n0 + (lane & 31)]; }
    LDS_WAIT(); asm volatile("" ::: "memory");
    const int c = lane & 7;
#pragma unroll
    for (int j = 0; j < 4; ++j) { const int n = (lane >> 3) + 8 * j; const LAS float* s = scr + (8 * c) * 33 + n;
        v4u o; o.x = pk2(s[0 * 33], s[1 * 33]); o.y = pk2(s[2 * 33], s[3 * 33]); o.z = pk2(s[4 * 33], s[5 * 33]); o.w = pk2(s[6 * 33], s[7 * 33]);
        *(GAS v4u*)(WT + (size_t)(drow0 + n) * K + k0 + 8 * c) = o; }
    LDS_WAIT(); asm volatile("" ::: "memory");
}
__device__ __forceinline__ int gu_row(int f, int up) { return (f >> 7) * 256 + up * 128 + (f & 127); }

__device__ __forceinline__ void phase_p0(KA a, LAS unsigned char* lds, int gw, int NGW, int wave, int lane) {
    unsigned char* ws = a->ws;
    LAS float* scr = (LAS float*)(lds + wave * 16384);
    for (int it = gw; it < 768; it += NGW) {
        const int l = it / 192, rem = it % 192, nb = rem >> 3, ks = rem & 7;
        const float* w = a->in[I_ADAW] + ((size_t)l * D + ks * 128) * 6144 + nb * 256 + lane * 4;
        const float* c0p = a->in[I_C] + ks * 128; const float* c1p = c0p + D;
        f32x4 a0 = {0.f, 0.f, 0.f, 0.f}, a1 = {0.f, 0.f, 0.f, 0.f};
#pragma unroll 8
        for (int k = 0; k < 128; ++k) { const f32x4 wv = *(const f32x4*)(w + (size_t)k * 6144); const float s0 = silu_f(c0p[k]), s1 = silu_f(c1p[k]); a0 += wv * s0; a1 += wv * s1; }
        float* mp = (float*)(ws + WS_MODP) + ((size_t)(l * 8 + ks) * 2) * 6144 + nb * 256 + lane * 4;
        *(f32x4*)mp = a0; *(f32x4*)(mp + 6144) = a1;
    }
    for (int it = gw; it < 64; it += NGW) {
        const int l = it >> 4, kb = it & 15, k = kb * 64 + lane;
        const float* gp = a->in[I_WIN] + ((size_t)l * D + k) * NPROJ_SRC + 3072;
        const f32x4 g0 = *(const f32x4*)gp, g1 = *(const f32x4*)(gp + 4), g2 = *(const f32x4*)(gp + 8), g3 = *(const f32x4*)(gp + 12);
        const float* w2 = a->in[I_GKW2] + (size_t)l * RANK * 256;
        bf16* wt = (bf16*)(ws + WS_WIN) + ((size_t)l * NPROJ + 3072) * D + k;
        for (int n = 0; n < 256; ++n) {
            float s = g0[0] * w2[n] + g0[1] * w2[256 + n] + g0[2] * w2[512 + n] + g0[3] * w2[768 + n];
            s += g1[0] * w2[1024 + n] + g1[1] * w2[1280 + n] + g1[2] * w2[1536 + n] + g1[3] * w2[1792 + n];
            s += g2[0] * w2[2048 + n] + g2[1] * w2[2304 + n] + g2[2] * w2[2560 + n] + g2[3] * w2[2816 + n];
            s += g3[0] * w2[3072 + n] + g3[1] * w2[3328 + n] + g3[2] * w2[3584 + n] + g3[3] * w2[3840 + n];
            wt[(size_t)n * D] = (bf16)f2bf(s);
        }
    }
    constexpr int I_IN = 16 * 96, I_OUT = 16 * 32, I_G = 16 * 88, I_D = 44 * 32;
    constexpr int PER_L = I_IN + I_OUT, PER_J = 2 * I_G + I_D, NIT = 4 * PER_L + 2 * PER_J;
    for (int it = gw; it < NIT; it += NGW) {
        int r = it;
        if (r < 4 * PER_L) { const int l = r / PER_L; r -= l * PER_L;
            if (r < I_IN) { const int kb = r / 96, nb = r % 96; transpose_item(a->in[I_WIN] + (size_t)l * D * NPROJ_SRC, NPROJ_SRC, D, (bf16*)(ws + WS_WIN) + (size_t)l * NPROJ * D, nb * 32, kb * 64, nb * 32, scr, lane); }
            else { r -= I_IN; const int kb = r / 32, nb = r % 32; transpose_item(a->in[I_WOUT] + (size_t)l * D * D, D, D, (bf16*)(ws + WS_WOUT) + (size_t)l * D * D, nb * 32, kb * 64, nb * 32, scr, lane); }
            continue; }
        r -= 4 * PER_L; const int j = r / PER_J; r -= j * PER_J;
        if (r < 2 * I_G) { const int up = r / I_G; r -= up * I_G; const int kb = r / 88, nb = r % 88;
            transpose_item(a->in[up ? I_FU : I_FG] + (size_t)j * D * FF, FF, D, (bf16*)(ws + WS_WGU) + (size_t)j * NGU * D, gu_row(nb * 32, up), kb * 64, nb * 32, scr, lane); }
        else { r -= 2 * I_G; const int kb = r / 32, nb = r % 32;
            transpose_item(a->in[I_FD] + (size_t)j * FF * D, D, FF, (bf16*)(ws + WS_WDN) + (size_t)j * D * FF, nb * 32, kb * 64, nb * 32, scr, lane); }
    }
}
__device__ __forceinline__ void moe_weights(KA a, int j, LAS unsigned char* lds, int gw, int NGW, int wave, int lane) {
    unsigned char* ws = a->ws;
    LAS float* scr = (LAS float*)(lds + wave * 16384);
    constexpr int I_G = 16 * 88, I_D = 44 * 32, PER_E = 2 * I_G + I_D;
    for (int it = gw; it < NE * PER_E; it += NGW) {
        const int e = it / PER_E; int r = it - e * PER_E;
        if (r < 2 * I_G) { const int up = r / I_G; r -= up * I_G; const int kb = r / 88, nb = r % 88;
            transpose_item(a->in[up ? I_MU : I_MG] + ((size_t)j * NE + e) * D * FF, FF, D, (bf16*)(ws + WS_MWGU) + (size_t)e * NGU * D, gu_row(nb * 32, up), kb * 64, nb * 32, scr, lane); }
        else { r -= 2 * I_G; const int kb = r / 32, nb = r % 32;
            transpose_item(a->in[I_MD] + ((size_t)j * NE + e) * FF * D, D, FF, (bf16*)(ws + WS_MWDN) + (size_t)e * D * FF, nb * 32, kb * 64, nb * 32, scr, lane); }
    }
}

__device__ __forceinline__ void phase_p1(KA a, LAS unsigned char* lds, int gw, int NGW, int lane) {
    OPAQUE_IDS;
    unsigned char* ws = a->ws;
    const float* modp = (const float*)(ws + WS_MODP); float* mod = (float*)(ws + WS_MOD);
    for (int i = bid * NTHR + tid; i < 4 * 2 * 6144; i += gridDim.x * NTHR) {
        const int l = i / 12288, r = i % 12288, b = r / 6144, n = r % 6144; float s = a->in[I_ADAB][l * 6144 + n];
#pragma unroll
        for (int ks = 0; ks < 8; ++ks) s += modp[((size_t)(l * 8 + ks) * 2 + b) * 6144 + n];
        mod[i] = s; }
    LAS float* mL = (LAS float*)lds;
    for (int i = tid; i < 4096; i += NTHR) { const int b = i >> 11, n = i & 2047; float s = a->in[I_ADAB][n];
#pragma unroll
        for (int ks = 0; ks < 8; ++ks) s += modp[((size_t)ks * 2 + b) * 6144 + n];
        mL[i] = s; }
    __syncthreads();
    const float* x = a->in[I_X]; bf16* U = (bf16*)(ws + WS_U);
    for (int m = gw; m < T; m += NGW) { const int b = m >= SEQ; const LAS float* sh = mL + b * 2048; const LAS float* sc = sh + 1024;
        const f32x4* xr = (const f32x4*)(x + (size_t)m * D) + lane; v2u* o8 = (v2u*)(U + (size_t)m * D) + lane;
#pragma unroll
        for (int j = 0; j < 4; ++j) { const f32x4 v = xr[64 * j]; const int c = 256 * j + 4 * lane;
            v2u w; w.x = pk2(v[0] * (1.f + sc[c]) + sh[c], v[1] * (1.f + sc[c + 1]) + sh[c + 1]); w.y = pk2(v[2] * (1.f + sc[c + 2]) + sh[c + 2], v[3] * (1.f + sc[c + 3]) + sh[c + 3]); o8[64 * j] = w; } }
    __syncthreads();
}

template <int SRC> __device__ __forceinline__ void phase_ln(KA a, const float* xin, const float* modl, int gate_off, const float* lng, const float* lnb, int nsh_off  , const float* modn, int gw, int NGW, int lane) {
    unsigned char* ws = a->ws; float* xout = a->out; bf16* U = (bf16*)(ws + WS_U);
    for (int m = gw; m < T; m += NGW) { const int b = m >= SEQ;
        const float* gate = modl + (size_t)b * 6144 + gate_off;
        f32x4 v[4]; float s = 0.f;
#pragma unroll
        for (int j = 0; j < 4; ++j) { const int c = 256 * j + 4 * lane; const f32x4 xv = *(const f32x4*)(xin + (size_t)m * D + c); const f32x4 gv = *(const f32x4*)(gate + c); f32x4 sv;
            if (SRC == 0) sv = *(const f32x4*)((const float*)(ws + WS_MIX) + (size_t)m * D + c);
            else { const v2u p0 = *(const v2u*)((const bf16*)(ws + WS_YS) + (size_t)m * 2 * D + c), p1 = *(const v2u*)((const bf16*)(ws + WS_YS) + (size_t)m * 2 * D + D + c);
                sv = (f32x4){bf_lo(p0.x) + bf_lo(p1.x), bf_hi(p0.x) + bf_hi(p1.x), bf_lo(p0.y) + bf_lo(p1.y), bf_hi(p0.y) + bf_hi(p1.y)}; }
            v[j] = xv * ALPHA + (gv + 1.f) * sv; s += (v[j][0] + v[j][1]) + (v[j][2] + v[j][3]); }
        const float mean = wave_sum(s) * (1.f / D); float s2 = 0.f;
#pragma unroll
        for (int j = 0; j < 4; ++j) { v[j] = v[j] - mean; s2 += (v[j][0] * v[j][0] + v[j][1] * v[j][1]) + (v[j][2] * v[j][2] + v[j][3] * v[j][3]); }
        const float rstd = 1.f / sqrtf(wave_sum(s2) * (1.f / D) + LN_EPS);
#pragma unroll
        for (int j = 0; j < 4; ++j) { const int c = 256 * j + 4 * lane; const f32x4 o = v[j] * rstd * *(const f32x4*)(lng + c) + *(const f32x4*)(lnb + c);
            *(f32x4*)(xout + (size_t)m * D + c) = o;
            if (nsh_off >= 0) { const f32x4 sh = *(const f32x4*)(modn + (size_t)b * 6144 + nsh_off + c), sc = *(const f32x4*)(modn + (size_t)b * 6144 + nsh_off + 1024 + c);
                const f32x4 uu = o * (sc + 1.f) + sh; v2u w; w.x = pk2(uu[0], uu[1]); w.y = pk2(uu[2], uu[3]); *(v2u*)(U + (size_t)m * D + c) = w; } }
    }
}

__device__ __forceinline__ float logsig16(float z) { const float ls = fminf(z, 0.f) - log1pf(__expf(-fabsf(z))); return fmaxf(ls * (1.f / 16.f), -1.f); }
__device__ __forceinline__ void phase_conv(KA a, int l) {
    OPAQUE_IDS;
    unsigned char* ws = a->ws; const bf16* P = (const bf16*)(ws + WS_PROJ); bf16* Y = (bf16*)(ws + WS_Y); const float* cw = a->in[I_CONVW] + (size_t)l * 3 * 512;
    for (int i = bid * NTHR + tid; i < T * 64; i += gridDim.x * NTHR) { const int t = i >> 6, c8 = (i & 63) * 8, ts = t & (SEQ - 1);
        const bf16* pr = P + (size_t)t * NPROJ;
        float z[3][8];
#pragma unroll
        for (int j = 0; j < 3; ++j) { const int back = 2 - j;
            if (ts >= back) { const v4u cc = *(const v4u*)(pr - (size_t)back * NPROJ + C_C + c8), hh = *(const v4u*)(pr - (size_t)back * NPROJ + C_H + c8);
                z[j][0] = bf_lo(cc.x) * bf_lo(hh.x); z[j][1] = bf_hi(cc.x) * bf_hi(hh.x); z[j][2] = bf_lo(cc.y) * bf_lo(hh.y); z[j][3] = bf_hi(cc.y) * bf_hi(hh.y);
                z[j][4] = bf_lo(cc.z) * bf_lo(hh.z); z[j][5] = bf_hi(cc.z) * bf_hi(hh.z); z[j][6] = bf_lo(cc.w) * bf_lo(hh.w); z[j][7] = bf_hi(cc.w) * bf_hi(hh.w); }
            else {
#pragma unroll
                for (int e = 0; e < 8; ++e) z[j][e] = 0.f; } }
        const v4u bb = *(const v4u*)(pr + C_B + c8);
        const float bv[8] = {bf_lo(bb.x), bf_hi(bb.x), bf_lo(bb.y), bf_hi(bb.y), bf_lo(bb.z), bf_hi(bb.z), bf_lo(bb.w), bf_hi(bb.w)};
        float o[8];
#pragma unroll
        for (int e = 0; e < 8; ++e) o[e] = bv[e] * (cw[c8 + e] * z[0][e] + cw[512 + c8 + e] * z[1][e] + cw[1024 + c8 + e] * z[2][e]);
        v4u w; w.x = pk2(o[0], o[1]); w.y = pk2(o[2], o[3]); w.z = pk2(o[4], o[5]); w.w = pk2(o[6], o[7]);
        *(v4u*)(Y + (size_t)t * D + c8) = w; }
}
__device__ __forceinline__ void unpack8(const v4u p, float (&f)[8]) { f[0] = bf_lo(p.x); f[1] = bf_hi(p.x); f[2] = bf_lo(p.y); f[3] = bf_hi(p.y); f[4] = bf_lo(p.z); f[5] = bf_hi(p.z); f[6] = bf_lo(p.w); f[7] = bf_hi(p.w); }
__device__ __forceinline__ void phase_gla_a(KA a, int l, LAS unsigned char* lds) {
    OPAQUE_IDS;
    unsigned char* ws = a->ws; const bf16* P = (const bf16*)(ws + WS_PROJ);
    LAS float* kL = (LAS float*)lds;
    LAS float* vL = kL + 64 * 65;
    LAS float* bL = vL + 64 * 128;
    const float* gkb = a->in[I_GKB] + (size_t)l * 256;
    float* KV = (float*)(ws + WS_KV); float* DEC = (float*)(ws + WS_DEC);
    for (int unit = bid; unit < NUNIT; unit += gridDim.x) {
        const int h = unit & 3, cn = unit >> 2; const size_t row0 = (size_t)cn * 64;
        const int j = tid >> 3, d8 = (tid & 7) * 8;
        { const bf16* pr = P + (row0 + j) * NPROJ; float f[8], g[8];
          unpack8(*(const v4u*)(pr + C_K + h * 64 + d8), f); unpack8(*(const v4u*)(pr + C_GK + h * 64 + d8), g);
#pragma unroll
          for (int e = 0; e < 8; ++e) { kL[j * 65 + d8 + e] = f[e]; bL[j * 64 + d8 + e] = logsig16(g[e] + gkb[h * 64 + d8 + e]); }
          const int c16 = (tid & 7) * 16;
          unpack8(*(const v4u*)(pr + C_V + h * 128 + c16), f); unpack8(*(const v4u*)(pr + C_V + h * 128 + c16 + 8), g);
#pragma unroll
          for (int e = 0; e < 8; ++e) { vL[j * 128 + c16 + e] = f[e]; vL[j * 128 + c16 + 8 + e] = g[e]; } }
        __syncthreads();
        if (tid < 64) { float s = 0.f; for (int jj = 0; jj < 64; ++jj) { s += bL[jj * 64 + tid]; bL[jj * 64 + tid] = s; } }
        __syncthreads();
#pragma unroll
        for (int e = 0; e < 8; ++e) kL[j * 65 + d8 + e] *= __expf(bL[63 * 64 + d8 + e] - bL[j * 64 + d8 + e]);
        if (tid < 64) DEC[(size_t)unit * 64 + tid] = __expf(bL[63 * 64 + tid]);
        __syncthreads();
        { const int v = tid & 127, dg = tid >> 7; float acc[16];
#pragma unroll
          for (int dd = 0; dd < 16; ++dd) acc[dd] = 0.f;
          for (int jj = 0; jj < 64; ++jj) { const float vv = vL[jj * 128 + v];
#pragma unroll
              for (int dd = 0; dd < 16; ++dd) acc[dd] += kL[jj * 65 + dg * 16 + dd] * vv; }
#pragma unroll
          for (int dd = 0; dd < 16; ++dd) KV[((size_t)unit * 64 + dg * 16 + dd) * 128 + v] = acc[dd]; }
        __syncthreads();
    }
}
__device__ __forceinline__ void phase_scan(KA a) {
    OPAQUE_IDS;
    unsigned char* ws = a->ws; const float* KV = (const float*)(ws + WS_KV); const float* DEC = (const float*)(ws + WS_DEC); float* ST = (float*)(ws + WS_ST);
    if (tid >= 256) return;
    for (int e = bid * 256 + tid; e < BATCH * NH * DK * DV; e += gridDim.x * 256) {
        const int v = e & 127, d = (e >> 7) & 63, h = (e >> 13) & 3, b = e >> 15; float S = 0.f;
#pragma unroll 8
        for (int n = 0; n < NCH; ++n) { const size_t unit = (size_t)(b * NCH + n) * 4 + h; const size_t idx = (unit * 64 + d) * 128 + v;
            const float kvv = KV[idx], dc = DEC[unit * 64 + d]; ST[idx] = S; S = dc * S + kvv; }
    }
}
__device__ __forceinline__ void phase_gla_b(KA a, int l, LAS unsigned char* lds) {
    OPAQUE_IDS;
    unsigned char* ws = a->ws; const bf16* P = (const bf16*)(ws + WS_PROJ); bf16* Y = (bf16*)(ws + WS_Y); const int lane = tid & 63, wave = tid >> 6;
    LAS float* qL = (LAS float*)lds;
    LAS float* kL = qL + 64 * 64;
    LAS float* vL = kL + 64 * 65;
    LAS float* bL = vL + 64 * 128;
    LAS float* SL = bL + 64 * 65;
    LAS float* red = SL + 64 * 128;
    const float* gkb = a->in[I_GKB] + (size_t)l * 256; const float* nw = a->in[I_NORMW] + (size_t)l * 128;
    const float* ST = (const float*)(ws + WS_ST);
    for (int unit = bid; unit < NUNIT; unit += gridDim.x) {
        const int h = unit & 3, cn = unit >> 2; const size_t row0 = (size_t)cn * 64;
        const int j = tid >> 3, d8 = (tid & 7) * 8;
        { const bf16* pr = P + (row0 + j) * NPROJ; float f[8], g[8], q[8];
          unpack8(*(const v4u*)(pr + C_Q + h * 64 + d8), q); unpack8(*(const v4u*)(pr + C_K + h * 64 + d8), f); unpack8(*(const v4u*)(pr + C_GK + h * 64 + d8), g);
#pragma unroll
          for (int e = 0; e < 8; ++e) { qL[j * 64 + d8 + e] = q[e]; kL[j * 65 + d8 + e] = f[e]; bL[j * 64 + d8 + e] = logsig16(g[e] + gkb[h * 64 + d8 + e]); }
          const int c16 = (tid & 7) * 16;
          unpack8(*(const v4u*)(pr + C_V + h * 128 + c16), f); unpack8(*(const v4u*)(pr + C_V + h * 128 + c16 + 8), g);
#pragma unroll
          for (int e = 0; e < 8; ++e) { vL[j * 128 + c16 + e] = f[e]; vL[j * 128 + c16 + 8 + e] = g[e]; }
          const f32x4* sp = (const f32x4*)(ST + (size_t)unit * 8192);
#pragma unroll
          for (int i = 0; i < 4; ++i) *(LAS f32x4*)(SL + (tid + i * 512) * 4) = sp[tid + i * 512]; }
        __syncthreads();
        if (tid < 64) { float s = 0.f; for (int jj = 0; jj < 64; ++jj) { s += bL[jj * 64 + tid]; bL[jj * 64 + tid] = s; } }
        __syncthreads();
#pragma unroll
        for (int e = 0; e < 8; ++e) { const float bb = bL[j * 64 + d8 + e]; qL[j * 64 + d8 + e] *= 0.125f * __expf(bb); kL[j * 65 + d8 + e] *= __expf(-bb); }
        __syncthreads();
        { const int jj = tid & 63, ig = tid >> 6; float s[8];
#pragma unroll
          for (int ii = 0; ii < 8; ++ii) s[ii] = 0.f;
          for (int d = 0; d < 64; ++d) { const float kk = kL[jj * 65 + d];
#pragma unroll
              for (int ii = 0; ii < 8; ++ii) s[ii] += qL[(ig * 8 + ii) * 64 + d] * kk; }
          __syncthreads();
#pragma unroll
          for (int ii = 0; ii < 8; ++ii) bL[(ig * 8 + ii) * 65 + jj] = (jj <= ig * 8 + ii) ? s[ii] : 0.f; }
        __syncthreads();
        { const int v = tid & 127, ig = tid >> 7; float acc[16];
#pragma unroll
          for (int ii = 0; ii < 16; ++ii) acc[ii] = 0.f;
          for (int jj = 0; jj < 64; ++jj) { const float vv = vL[jj * 128 + v];
#pragma unroll
              for (int ii = 0; ii < 16; ++ii) acc[ii] += bL[(ig * 16 + ii) * 65 + jj] * vv; }
          for (int d = 0; d < 64; ++d) { const float sv = SL[d * 128 + v];
#pragma unroll
              for (int ii = 0; ii < 16; ++ii) acc[ii] += qL[(ig * 16 + ii) * 64 + d] * sv; }
#pragma unroll
          for (int ii = 0; ii < 16; ++ii) { const float ss = wave_sum(acc[ii] * acc[ii]); if (lane == 0) red[wave * 16 + ii] = ss; }
          __syncthreads();
          const float nwv = nw[v];
#pragma unroll
          for (int ii = 0; ii < 16; ++ii) { const float ms = (red[(2 * ig) * 16 + ii] + red[(2 * ig + 1) * 16 + ii]) * (1.f / 128.f);
              const size_t t = row0 + ig * 16 + ii; const float gg = bf1(P[t * NPROJ + C_G + h * 128 + v]);
              const float o = acc[ii] * (1.f / sqrtf(ms + RMS_EPS)) * nwv * silu_f(gg);
              Y[t * D + 512 + h * 128 + v] = (bf16)f2bf(o); } }
        __syncthreads();
    }
}

__device__ __forceinline__ void phase_route1(KA a, int l, LAS unsigned char* lds) {
    OPAQUE_IDS;
    unsigned char* ws = a->ws; const int lane = tid & 63, wave = tid >> 6; const int jm = l >> 1;
    int* tok_e = (int*)(ws + WS_MISC + MS_TOKE); float* tok_w = (float*)(ws + WS_MISC + MS_TOKW); int* cnt = (int*)(ws + WS_MISC + MS_CNT); int* row_tok = (int*)(ws + WS_MISC + MS_ROWTOK);
    for (int i = bid * NTHR + tid; i < MOE_ROWS; i += gridDim.x * NTHR) row_tok[i] = -1;
    LAS float* rwL = (LAS float*)lds;
    LAS int* cL = (LAS int*)(lds + 32768);
    const float* rw = a->in[I_RW] + (size_t)jm * D * NE;
    for (int i = tid; i < D * NE; i += NTHR) rwL[i] = rw[i];
    if (tid < 8) cL[tid] = 0;
    __syncthreads();
    const float* mod = (const float*)(ws + WS_MOD) + (size_t)l * 2 * 6144;
    const int tpw = T / (int)gridDim.x;
    for (int i = wave; i < tpw; i += NWAVES) { const int t = bid * tpw + i, b = t >= SEQ;
        float lg[8];
#pragma unroll
        for (int e = 0; e < 8; ++e) lg[e] = 0.f;
#pragma unroll
        for (int jj = 0; jj < 4; ++jj) { const int c = 256 * jj + 4 * lane; const f32x4 xv = *(const f32x4*)(a->out + (size_t)t * D + c);
            const f32x4 sh = *(const f32x4*)(mod + (size_t)b * 6144 + 3072 + c), sc = *(const f32x4*)(mod + (size_t)b * 6144 + 4096 + c); const f32x4 uu = xv * (sc + 1.f) + sh;
#pragma unroll
            for (int q = 0; q < 4; ++q) { const f32x4 w0 = *(const LAS f32x4*)(rwL + (c + q) * 8), w1 = *(const LAS f32x4*)(rwL + (c + q) * 8 + 4);
                lg[0] += uu[q] * w0[0]; lg[1] += uu[q] * w0[1]; lg[2] += uu[q] * w0[2]; lg[3] += uu[q] * w0[3]; lg[4] += uu[q] * w1[0]; lg[5] += uu[q] * w1[1]; lg[6] += uu[q] * w1[2]; lg[7] += uu[q] * w1[3]; } }
#pragma unroll
        for (int e = 0; e < 8; ++e) lg[e] = wave_sum(lg[e]);
        int e0 = 0; float l0 = lg[0];
#pragma unroll
        for (int e = 1; e < 8; ++e) if (lg[e] > l0) { l0 = lg[e]; e0 = e; }
        int e1 = -1; float l1 = -3.0e38f;
#pragma unroll
        for (int e = 0; e < 8; ++e) if (e != e0 && lg[e] > l1) { l1 = lg[e]; e1 = e; }
        const float p1 = __expf(l1 - l0), w0 = 1.f / (1.f + p1), w1 = p1 * w0;
        if (lane == 0) { tok_e[t * 2] = e0; tok_e[t * 2 + 1] = e1; tok_w[t * 2] = w0; tok_w[t * 2 + 1] = w1; __hip_atomic_fetch_add(&cL[e0], 1, __ATOMIC_RELAXED, __HIP_MEMORY_SCOPE_WORKGROUP); __hip_atomic_fetch_add(&cL[e1], 1, __ATOMIC_RELAXED, __HIP_MEMORY_SCOPE_WORKGROUP); }
    }
    __syncthreads();
    if (tid < 8) cnt[bid * 8 + tid] = cL[tid];
    __syncthreads();
}
__device__ __forceinline__ void phase_route2(KA a, LAS unsigned char* lds) {
    OPAQUE_IDS;
    unsigned char* ws = a->ws; const int lane = tid & 63, wave = tid >> 6; const int G = gridDim.x;
    const int* tok_e = (const int*)(ws + WS_MISC + MS_TOKE); const float* tok_w = (const float*)(ws + WS_MISC + MS_TOKW); const int* cnt = (const int*)(ws + WS_MISC + MS_CNT);
    int* row_tok = (int*)(ws + WS_MISC + MS_ROWTOK); float* row_w = (float*)(ws + WS_MISC + MS_ROWW); int* tile_e = (int*)(ws + WS_MISC + MS_TILEE); int* meta = (int*)(ws + WS_MISC + MS_META);
    LAS int* baseL = (LAS int*)lds;
    LAS int* segL = baseL + 16;
    LAS int* totL = baseL + 32;
    LAS int* eL = baseL + 64;
    LAS int* posL = baseL + 64 + 512;
    if (tid < 8) { int tot = 0, bef = 0; for (int w = 0; w < G; ++w) { const int c = cnt[w * 8 + tid]; tot += c; if (w < (int)bid) bef += c; } baseL[tid] = bef; totL[tid] = tot; }
    __syncthreads();
    if (tid == 0) { int s = 0; for (int e = 0; e < 8; ++e) { segL[e] = s; s += (totL[e] + 255) & ~255; } segL[8] = s;
        if (bid == 0) { meta[0] = s >> 8; for (int e = 0; e < 8; ++e) for (int tt = segL[e] >> 8; tt < (segL[e + 1] >> 8); ++tt) tile_e[tt] = e; } }
    __syncthreads();
    const int tpw = T / G, npair = 2 * tpw;
    if (tid < npair) eL[tid] = tok_e[bid * npair + tid];
    __syncthreads();
    if (tid < npair) { const int e = eL[tid]; int rank = 0; for (int i = 0; i < tid; ++i) rank += (eL[i] == e) ? 1 : 0;
        const int pos = segL[e] + baseL[e] + rank; posL[tid] = pos; row_tok[pos] = bid * npair + tid; row_w[pos] = tok_w[bid * npair + tid]; }
    __syncthreads();
    const bf16* U = (const bf16*)(ws + WS_U); bf16* XS = (bf16*)(ws + WS_XS);
    for (int i = wave; i < npair; i += NWAVES) { const int t = bid * tpw + (i >> 1), pos = posL[i];
        const v4u* s = (const v4u*)(U + (size_t)t * D) + lane; v4u* d = (v4u*)(XS + (size_t)pos * D) + lane; d[0] = s[0]; d[64] = s[64]; }
    __syncthreads();
}

constexpr int PH_PER_LAYER = 11, N_PHASES = 2 + DEPTH * PH_PER_LAYER;
__global__ void __launch_bounds__(NTHR, 2) trunk_fwd(Args args_unused) {
    extern __shared__ __attribute__((aligned(16))) unsigned char lds_raw[];
    LAS unsigned char* lds = (LAS unsigned char*)lds_raw;
    const int G = gridDim.x;
    volatile LAS unsigned* MISC = (volatile LAS unsigned*)(lds + MISC_OFF);
    if (threadIdx.x < 32) MISC[threadIdx.x] = 0u;
    __syncthreads();
    XcdBarrier bar; bar.bar = nullptr; bar.x = 0; bar.st = MISC;
    int lo, hi;
    { KA a = kargs(); lo = a->ph_lo; hi = a->ph_hi; bar.bar = (unsigned*)(a->ws + WS_CTL) + CW_BAR; if (!MK_MULTI) bar = xcd_barrier_post(bar.bar, MISC); }
#define IN(k) (lo <= (k) && (k) < hi)
#define SEAM(k) do { if (!MK_MULTI && (k) + 1 < hi) xcd_barrier(bar); } while (0)
#define WAVE_IDS int tid = threadIdx.x; asm volatile("" : "+v"(tid)); const int lane = tid & 63, wave = __builtin_amdgcn_readfirstlane(tid >> 6), gw = blockIdx.x * NWAVES + wave, NGW = G * NWAVES; (void)lane; (void)gw; (void)NGW;

    if (IN(0)) { KA a = kargs(); WAVE_IDS; phase_p0(a, lds, gw, NGW, wave, lane); SEAM(0); }
    if (IN(1)) { KA a = kargs(); WAVE_IDS; phase_p1(a, lds, gw, NGW, lane); SEAM(1); }

    for (int l = 0; l < DEPTH; ++l) {
        const int pb = 2 + l * PH_PER_LAYER; const bool moe = (l & 1) != 0; const int jm = l >> 1;
        if (IN(pb + 0)) { KA a = kargs(); unsigned char* ws = a->ws;
            pg8::Gemm g{(const bf16*)(ws + WS_U), (const bf16*)(ws + WS_WIN) + (size_t)l * NPROJ * D, T, NPROJ, D}; pg8::StaticOrder S; S.init(T, NPROJ, G, (int)blockIdx.x);
            pg8::EpiBf16 E{(bf16*)(ws + WS_PROJ), NPROJ};
            pg8::gemm_phase<pg8::EpiBf16, pg8::StaticOrder, true, true>(lds, g, S, E); SEAM(pb + 0); }
        if (IN(pb + 1)) { KA a = kargs(); phase_conv(a, l); phase_gla_a(a, l, lds); SEAM(pb + 1); }
        if (IN(pb + 2)) { KA a = kargs(); WAVE_IDS; phase_scan(a); if (moe) moe_weights(a, jm, lds, gw, NGW, wave, lane); SEAM(pb + 2); }
        if (IN(pb + 3)) { KA a = kargs(); phase_gla_b(a, l, lds); SEAM(pb + 3); }
        if (IN(pb + 4)) { KA a = kargs(); unsigned char* ws = a->ws;
            pg8::Gemm g{(const bf16*)(ws + WS_Y), (const bf16*)(ws + WS_WOUT) + (size_t)l * D * D, T, D, D}; pg8::StaticOrder S; S.init(T, D, G, (int)blockIdx.x);
            pg8::EpiF32 E{(float*)(ws + WS_MIX), D};
            pg8::gemm_phase<pg8::EpiF32, pg8::StaticOrder, true, true>(lds, g, S, E); SEAM(pb + 4); }
        if (IN(pb + 5)) { KA a = kargs(); WAVE_IDS; const float* modl = (const float*)(a->ws + WS_MOD) + (size_t)l * 2 * 6144;
            phase_ln<0>(a, l == 0 ? a->in[I_X] : a->out, modl, 2048, a->in[I_LN1G] + (size_t)l * D, a->in[I_LN1B] + (size_t)l * D, 3072, modl, gw, NGW, lane); SEAM(pb + 5); }
        if (moe) {
            if (IN(pb + 6)) { KA a = kargs(); phase_route1(a, l, lds); SEAM(pb + 6); }
            if (IN(pb + 7)) { KA a = kargs(); phase_route2(a, lds); SEAM(pb + 7); }
            if (IN(pb + 8)) { KA a = kargs(); unsigned char* ws = a->ws; const int ntile = *(const int*)(ws + WS_MISC + MS_META);
                pg8::Gemm g{(const bf16*)(ws + WS_XS), (const bf16*)(ws + WS_MWGU), ntile * 256, NGU, D}; pg8::MoeOrder S; S.init(ntile * 256, NGU, G, (int)blockIdx.x); S.tile_e = (const int*)(ws + WS_MISC + MS_TILEE);
                pg8::EpiSwiGLU E{(bf16*)(ws + WS_H), FF};
                pg8::gemm_phase<pg8::EpiSwiGLU, pg8::MoeOrder, true, true>(lds, g, S, E); SEAM(pb + 8); }
            if (IN(pb + 9)) { KA a = kargs(); unsigned char* ws = a->ws; const int ntile = *(const int*)(ws + WS_MISC + MS_META);
                pg8::Gemm g{(const bf16*)(ws + WS_H), (const bf16*)(ws + WS_MWDN), ntile * 256, D, FF}; pg8::MoeOrder S; S.init(ntile * 256, D, G, (int)blockIdx.x); S.tile_e = (const int*)(ws + WS_MISC + MS_TILEE);
                pg8::EpiMoeDown E{(bf16*)(ws + WS_YS), D, (const int*)(ws + WS_MISC + MS_ROWTOK), (const float*)(ws + WS_MISC + MS_ROWW)};
                pg8::gemm_phase<pg8::EpiMoeDown, pg8::MoeOrder, true, true>(lds, g, S, E); SEAM(pb + 9); }
            if (IN(pb + 10)) { KA a = kargs(); WAVE_IDS; const float* modl = (const float*)(a->ws + WS_MOD) + (size_t)l * 2 * 6144; const float* modn = (const float*)(a->ws + WS_MOD) + (size_t)(l + 1 < DEPTH ? l + 1 : l) * 2 * 6144;
                phase_ln<1>(a, a->out, modl, 5120, a->in[I_LN2G] + (size_t)l * D, a->in[I_LN2B] + (size_t)l * D, l + 1 < DEPTH ? 0 : -1, modn, gw, NGW, lane); SEAM(pb + 10); }
        } else {
            if (IN(pb + 8)) { KA a = kargs(); unsigned char* ws = a->ws;
                pg8::Gemm g{(const bf16*)(ws + WS_U), (const bf16*)(ws + WS_WGU) + (size_t)jm * NGU * D, T, NGU, D}; pg8::StaticOrder S; S.init(T, NGU, G, (int)blockIdx.x);
                pg8::EpiSwiGLU E{(bf16*)(ws + WS_H), FF};
                pg8::gemm_phase<pg8::EpiSwiGLU, pg8::StaticOrder, true, true>(lds, g, S, E); SEAM(pb + 8); }
            if (IN(pb + 9)) { KA a = kargs(); unsigned char* ws = a->ws;
                pg8::Gemm g{(const bf16*)(ws + WS_H), (const bf16*)(ws + WS_WDN) + (size_t)jm * D * FF, T, D, FF}; pg8::StaticOrder S; S.init(T, D, G, (int)blockIdx.x);
                pg8::EpiF32 E{(float*)(ws + WS_MIX), D};
                pg8::gemm_phase<pg8::EpiF32, pg8::StaticOrder, true, true>(lds, g, S, E); SEAM(pb + 9); }
            if (IN(pb + 10)) { KA a = kargs(); WAVE_IDS; const float* modl = (const float*)(a->ws + WS_MOD) + (size_t)l * 2 * 6144; const float* modn = (const float*)(a->ws + WS_MOD) + (size_t)(l + 1 < DEPTH ? l + 1 : l) * 2 * 6144;
                phase_ln<0>(a, a->out, modl, 5120, a->in[I_LN2G] + (size_t)l * D, a->in[I_LN2B] + (size_t)l * D, l + 1 < DEPTH ? 0 : -1, modn, gw, NGW, lane); SEAM(pb + 10); }
        }
    }
#undef IN
#undef SEAM
#undef WAVE_IDS
}

extern "C" void kernel_launch(void* const* d_in, const int* in_sizes, int n_in, void* d_out, int out_size, void* d_ws, size_t ws_size, hipStream_t stream) {
    static int grid = 0;
    if (grid == 0) {
        if (n_in != 21 || in_sizes[0] != T * D || out_size != T * D || ws_size < WS_END) { fprintf(stderr, "kernel_launch: unexpected shapes (n_in %d, in0 %d, out %d, ws %zu < %zu); nothing launched\n", n_in, n_in > 0 ? in_sizes[0] : -1, out_size, ws_size, (size_t)WS_END); grid = -1; return; }
        int dev = 0, cus = 0, per_cu = 0;
        if (hipGetDevice(&dev) != hipSuccess || hipDeviceGetAttribute(&cus, hipDeviceAttributeMultiprocessorCount, dev) != hipSuccess) { grid = -1; return; }
        if (hipFuncSetAttribute((const void*)trunk_fwd, hipFuncAttributeMaxDynamicSharedMemorySize, LDS_BYTES) != hipSuccess) { fprintf(stderr, "kernel_launch: hipFuncSetAttribute failed\n"); grid = -1; return; }
        if (hipOccupancyMaxActiveBlocksPerMultiprocessor(&per_cu, (const void*)trunk_fwd, NTHR, LDS_BYTES) != hipSuccess || per_cu < 1) fprintf(stderr, "kernel_launch: occupancy query reports %d\n", per_cu);
        (void)hipGetLastError();
        grid = cus;
        if (T % grid != 0 || (2 * T / grid) > 512) { fprintf(stderr, "kernel_launch: grid %d unsupported\n", grid); grid = -1; return; }
    }
    if (grid < 0) return;
    if (hipMemsetAsync((char*)d_ws + WS_CTL, 0, CTL_ZERO_BYTES, stream) != hipSuccess) return;
    Args a{};
    for (int i = 0; i < 21; ++i) a.in[i] = (const float*)d_in[i];
    a.out = (float*)d_out; a.ws = (unsigned char*)d_ws; a.li = 0; a.pad = 0;
#if MK_MULTI
    for (int p = 0; p < N_PHASES; ++p) {
        const int r = p - 2, slot = r >= 0 ? r % PH_PER_LAYER : -1, l = r >= 0 ? r / PH_PER_LAYER : 0;
        if (slot >= 0 && (l & 1) == 0 && (slot == 6 || slot == 7)) continue;
        a.ph_lo = p; a.ph_hi = p + 1;
        hipLaunchKernelGGL(trunk_fwd, dim3(grid), dim3(NTHR), LDS_BYTES, stream, a);
    }
#else
    a.ph_lo = 0; a.ph_hi = N_PHASES;
    hipLaunchKernelGGL(trunk_fwd, dim3(grid), dim3(NTHR), LDS_BYTES, stream, a);
#endif
    const hipError_t le = hipPeekAtLastError();
    if (le != hipSuccess) fprintf(stderr, "kernel_launch: launch failed: %s\n", hipGetErrorName(le));
}
```

```cpp
#include <hip/hip_runtime.h>
#include <cstdio>
#include <cstdint>

#ifndef GLA_MFMA
#define GLA_MFMA 1
#endif
#ifndef EN
#define EN 0x1fff
#endif
#define EN_(b) (((EN) >> (b)) & 1)
#ifndef MK_MULTI
#define MK_MULTI 0
#endif

namespace pg8 {
#define PG8_LAS __attribute__((address_space(3)))
typedef unsigned short bf16_t;
typedef short bf16x8 __attribute__((ext_vector_type(8)));
typedef float f32x4 __attribute__((ext_vector_type(4)));
typedef unsigned u32x4 __attribute__((ext_vector_type(4)));
constexpr int BM = 256, BK = 64, HALF = 128, HTB = HALF * BK * 2  , STAGE_BYTES = 8 * HTB, NXCD = 8, WGM = 8;

__host__ __device__ __forceinline__ int lds_byte(int r, int c) { const int st = (r >> 4) * 2 + (c >> 5), rr = r & 15, cc = c & 31, ob = rr * 64 + cc * 2; return st * 1024 + (ob ^ (((ob >> 9) & 1) << 5)); }
__host__ __device__ __forceinline__ void stage_rc(int b, int& R, int& C) { const int st = b / 1024, sb = b % 1024, swz = sb ^ (((sb >> 9) & 1) << 5); R = (st >> 1) * 16 + swz / 64; C = (st & 1) * 32 + (swz % 64) / 2; }
__host__ __device__ __forceinline__ int perm32(int rho) { const int n = rho >> 4, i = rho & 15; return 8 * (i >> 2) + 4 * n + (i & 3); }

struct Unit { int pm, pn; };
struct Gemm { const bf16_t* A; const bf16_t* Bt; int M, N, K; };

struct StaticOrder {
    int nM, nN, nwg, G, c;
    __host__ __device__ void init(int M, int N, int G_, int c_) { nM = M / BM; nN = N / BM; nwg = nM * nN; G = G_; c = c_; }
    __host__ __device__ bool next(int i, Unit& u) const {
        const long L = (long)i * G + c; if (L >= nwg) return false;
        int wgid = (int)L; { const int q = nwg / NXCD, r = nwg % NXCD, xcd = wgid % NXCD, off = wgid / NXCD; wgid = (xcd < r ? xcd * (q + 1) : r * (q + 1) + (xcd - r) * q) + off; }
        const int nig = WGM * nN, gid = wgid / nig, fm = gid * WGM, gsz = (nM - fm) < WGM ? (nM - fm) : WGM;
        u.pm = fm + ((wgid % nig) % gsz); u.pn = (wgid % nig) / gsz; return true;
    }
    __device__ __forceinline__ const char* b_tile(const Gemm& g, const Unit& u) const { return (const char*)g.Bt + (size_t)u.pn * BM * g.K * 2; }
    __device__ __forceinline__ void a_ready(const Unit&) const {}
    __device__ __forceinline__ void done(const Unit&) const {}
};
struct MoeOrder : StaticOrder {
    const int* tile_e;
    __device__ __forceinline__ const char* b_tile(const Gemm& g, const Unit& u) const {
        const int e = __builtin_amdgcn_readfirstlane(tile_e[u.pm]);
        return (const char*)g.Bt + ((size_t)e * g.N + (size_t)u.pn * BM) * g.K * 2; }
};

__device__ __forceinline__ unsigned cvt_pk_bf16(float lo, float hi) { unsigned r; asm volatile("v_cvt_pk_bf16_f32 %0, %1, %2" : "=v"(r) : "v"(lo), "v"(hi)); return r; }

struct EpiBf16 {
    static constexpr bool PERM = true, AFTER_DRAIN = false;
    bf16_t* O; int ldc;
    __device__ __forceinline__ void operator()(const f32x4 (&acc)[2][2][4][2], const Unit& u, int wr, int wc, int fr, int fq) const {
        const int row0 = u.pm * BM + wr * 64 + fr, col0 = u.pn * BM + wc * 32 + 8 * fq;
#pragma unroll
        for (int ai = 0; ai < 2; ++ai)
#pragma unroll
            for (int m = 0; m < 4; ++m) { bf16_t* rowp = O + (size_t)(row0 + ai * HALF + m * 16) * ldc + col0;
#pragma unroll
                for (int bj = 0; bj < 2; ++bj) { const f32x4 v0 = acc[ai][bj][m][0], v1 = acc[ai][bj][m][1];
                    u32x4 w; w.x = cvt_pk_bf16(v0[0], v0[1]); w.y = cvt_pk_bf16(v0[2], v0[3]); w.z = cvt_pk_bf16(v1[0], v1[1]); w.w = cvt_pk_bf16(v1[2], v1[3]);
                    *(u32x4*)(rowp + bj * HALF) = w; } }
    }
};
__device__ __forceinline__ float silu1(float x) { return x * __builtin_amdgcn_rcpf(1.0f + __builtin_amdgcn_exp2f(-1.44269504089f * x)); }
struct EpiSwiGLU {
    static constexpr bool PERM = true, AFTER_DRAIN = false;
    bf16_t* H; int ldh;
    __device__ __forceinline__ void operator()(const f32x4 (&acc)[2][2][4][2], const Unit& u, int wr, int wc, int fr, int fq) const {
        const int row0 = u.pm * BM + wr * 64 + fr, col0 = u.pn * HALF + wc * 32 + 8 * fq;
#pragma unroll
        for (int ai = 0; ai < 2; ++ai)
#pragma unroll
            for (int m = 0; m < 4; ++m) { bf16_t* rowp = H + (size_t)(row0 + ai * HALF + m * 16) * ldh + col0;
                const f32x4 g0 = acc[ai][0][m][0], g1 = acc[ai][0][m][1], u0 = acc[ai][1][m][0], u1 = acc[ai][1][m][1];
                u32x4 w;
                w.x = cvt_pk_bf16(silu1(g0[0]) * u0[0], silu1(g0[1]) * u0[1]); w.y = cvt_pk_bf16(silu1(g0[2]) * u0[2], silu1(g0[3]) * u0[3]);
                w.z = cvt_pk_bf16(silu1(g1[0]) * u1[0], silu1(g1[1]) * u1[1]); w.w = cvt_pk_bf16(silu1(g1[2]) * u1[2], silu1(g1[3]) * u1[3]);
                *(u32x4*)rowp = w; }
    }
};
struct EpiF32 {
    static constexpr bool PERM = false, AFTER_DRAIN = false;
    float* C; int ldc;
    __device__ __forceinline__ void operator()(const f32x4 (&acc)[2][2][4][2], const Unit& u, int wr, int wc, int fr, int fq) const {
        const int row0 = u.pm * BM + wr * 64 + fr, col0 = u.pn * BM + wc * 32 + 4 * fq;
#pragma unroll
        for (int ai = 0; ai < 2; ++ai)
#pragma unroll
            for (int m = 0; m < 4; ++m) { float* rowp = C + (size_t)(row0 + ai * HALF + m * 16) * ldc + col0;
#pragma unroll
                for (int bj = 0; bj < 2; ++bj)
#pragma unroll
                    for (int n = 0; n < 2; ++n) *(f32x4*)(rowp + bj * HALF + n * 16) = acc[ai][bj][m][n]; }
    }
};
struct EpiMoeDown {
    static constexpr bool PERM = true, AFTER_DRAIN = false;
    bf16_t* Y; int ldc; const int* row_tok; const float* row_w;
    __device__ __forceinline__ void operator()(const f32x4 (&acc)[2][2][4][2], const Unit& u, int wr, int wc, int fr, int fq) const {
        const int row0 = u.pm * BM + wr * 64 + fr, col0 = u.pn * BM + wc * 32 + 8 * fq;
#pragma unroll
        for (int ai = 0; ai < 2; ++ai)
#pragma unroll
            for (int m = 0; m < 4; ++m) { const int r = row0 + ai * HALF + m * 16; const int ts = row_tok[r]; const float w8 = row_w[r];
                if (ts >= 0) { bf16_t* rowp = Y + (size_t)ts * ldc + col0;
#pragma unroll
                    for (int bj = 0; bj < 2; ++bj) { const f32x4 v0 = acc[ai][bj][m][0] * w8, v1 = acc[ai][bj][m][1] * w8;
                        u32x4 w; w.x = cvt_pk_bf16(v0[0], v0[1]); w.y = cvt_pk_bf16(v0[2], v0[3]); w.z = cvt_pk_bf16(v1[0], v1[1]); w.w = cvt_pk_bf16(v1[2], v1[3]);
                        *(u32x4*)(rowp + bj * HALF) = w; } } }
    }
};

template <class Epi, class Sched, bool ALIGN_EPI = false, bool SP2 = false>
__device__ __forceinline__ void gemm_phase(PG8_LAS unsigned char* lds, const Gemm g, const Sched& S, const Epi& E) {
    int tid_ = threadIdx.x; asm volatile("" : "+v"(tid_));
    const int tid = tid_, wid = __builtin_amdgcn_readfirstlane(tid >> 6), lane = tid & 63, wr = wid >> 2, wc = wid & 3, fr = lane & 15, fq = lane >> 4;
    const int K = g.K, nt = K / BK;
    unsigned voffA[2], voffB[2];
#pragma unroll
    for (int i = 0; i < 2; ++i) { int R, C; stage_rc(tid * 16 + i * 8192, R, C); const int Rb = Epi::PERM ? ((R & ~31) + perm32(R & 31)) : R;
        voffA[i] = (unsigned)(R * K + C) * 2u; voffB[i] = (unsigned)(Rb * K + C) * 2u; }
    const size_t kstep = (size_t)(BK * 2);
    const size_t hstep = (size_t)HALF * K * 2;
    const size_t tstep = 2 * hstep;
    const unsigned ldsw = (unsigned)wid * 1024u;
    const int aoff = lds_byte(wr * 64 + fr, fq * 8), boff = lds_byte(wc * 32 + fr, fq * 8);
#define PG8_SA(b, h) (((b) * 2 + (h)) * HTB)
#define PG8_SB(b, h) ((4 + (b) * 2 + (h)) * HTB)
#define PG8_STAGE(bufoff, gbase, voff) do { _Pragma("unroll") for (int _i = 0; _i < 2; ++_i) \
        __builtin_amdgcn_global_load_lds((const unsigned*)((const char*)(gbase) + (voff)[_i]), (PG8_LAS unsigned*)(lds + (bufoff) + ldsw + _i * 8192), 16, 0, 0); } while (0)
#define PG8_LDA(dst, b, h) do { _Pragma("unroll") for (int m = 0; m < 4; ++m) _Pragma("unroll") for (int k = 0; k < 2; ++k) dst[m][k] = *(const PG8_LAS bf16x8*)(lds + PG8_SA(b, h) + aoff + m * 2048 + k * 1024); } while (0)
#define PG8_LDB(dst, b, h) do { _Pragma("unroll") for (int n = 0; n < 2; ++n) _Pragma("unroll") for (int k = 0; k < 2; ++k) dst[n][k] = *(const PG8_LAS bf16x8*)(lds + PG8_SB(b, h) + boff + n * 2048 + k * 1024); } while (0)
#define PG8_MMA(ai, bj, At, Bt) do { __builtin_amdgcn_s_setprio(1); _Pragma("unroll") for (int m = 0; m < 4; ++m) _Pragma("unroll") for (int n = 0; n < 2; ++n) _Pragma("unroll") for (int k = 0; k < 2; ++k) \
        acc[ai][bj][m][n] = __builtin_amdgcn_mfma_f32_16x16x32_bf16(Bt[n][k], At[m][k], acc[ai][bj][m][n], 0, 0, 0); __builtin_amdgcn_s_setprio(0); } while (0)
#define PG8_WAIT_V(n) asm volatile("s_waitcnt vmcnt(" #n ")" ::: "memory")
#define PG8_WAIT_L(n) asm volatile("s_waitcnt lgkmcnt(" #n ")" ::: "memory")
#define PG8_BAR __builtin_amdgcn_s_barrier()
#define PG8_SCHED __builtin_amdgcn_sched_barrier(0)
    Unit cur, nxt; int ui = 0;
    if (!S.next(0, cur)) return;
    f32x4 acc[2][2][4][2];
#pragma unroll
    for (int a = 0; a < 2; ++a)
#pragma unroll
        for (int b = 0; b < 2; ++b)
#pragma unroll
            for (int m = 0; m < 4; ++m)
#pragma unroll
                for (int n = 0; n < 2; ++n) acc[a][b][m][n] = (f32x4){0.f, 0.f, 0.f, 0.f};
    bf16x8 At[4][2], B0[2][2], B1[2][2];
    const char* cA = (const char*)g.A + (size_t)cur.pm * tstep; const char* cB = S.b_tile(g, cur);
    S.a_ready(cur);
    if constexpr (SP2) {
        PG8_STAGE(PG8_SB(0, 0), cB, voffB); PG8_STAGE(PG8_SB(0, 1), cB + hstep, voffB); PG8_STAGE(PG8_SA(0, 0), cA, voffA); PG8_STAGE(PG8_SA(0, 1), cA + hstep, voffA);
        if (wr == 1) PG8_BAR;
        PG8_WAIT_V(2); PG8_BAR;
        PG8_STAGE(PG8_SB(1, 0), cB + kstep, voffB); PG8_STAGE(PG8_SA(1, 0), cA + kstep, voffA); PG8_STAGE(PG8_SB(1, 1), cB + hstep + kstep, voffB);
        PG8_WAIT_V(6); PG8_BAR;
    } else {
        PG8_STAGE(PG8_SB(0, 0), cB, voffB); PG8_STAGE(PG8_SA(0, 0), cA, voffA); PG8_STAGE(PG8_SB(0, 1), cB + hstep, voffB); PG8_STAGE(PG8_SA(0, 1), cA + hstep, voffA);
        if (wr == 1) PG8_BAR;
        PG8_WAIT_V(4); PG8_BAR;
        PG8_STAGE(PG8_SB(1, 0), cB + kstep, voffB); PG8_STAGE(PG8_SA(1, 0), cA + kstep, voffA); PG8_STAGE(PG8_SB(1, 1), cB + hstep + kstep, voffB);
        PG8_WAIT_V(6); PG8_BAR;
    }
    for (;;) {
        const bool has_next = S.next(ui + 1, nxt);
        const char* nA = has_next ? (const char*)g.A + (size_t)nxt.pm * tstep : cA; const char* nB = has_next ? S.b_tile(g, nxt) : cB;
        for (int t = 0; t < nt; t += 2) {
            const bool last = (t == nt - 2);
            const char* a1 = cA + (size_t)(t + 1) * kstep;
            const char* a2 = last ? nA : cA + (size_t)(t + 2) * kstep; const char* b2 = last ? nB : cB + (size_t)(t + 2) * kstep;
            const char* a3 = a2 + kstep; const char* b3 = b2 + kstep;
            if (last && has_next) S.a_ready(nxt);
            if constexpr (SP2) {
            PG8_LDB(B0, 0, 0); PG8_LDB(B1, 0, 1); PG8_SCHED; PG8_LDA(At, 0, 0); PG8_STAGE(PG8_SA(1, 1), a1 + hstep, voffA);
            PG8_WAIT_V(8); PG8_WAIT_L(0); PG8_BAR; PG8_MMA(0, 0, At, B0); PG8_MMA(0, 1, At, B1); PG8_BAR; PG8_SCHED;
            PG8_LDA(At, 0, 1); PG8_STAGE(PG8_SB(0, 0), b2, voffB); PG8_STAGE(PG8_SB(0, 1), b2 + hstep, voffB); PG8_STAGE(PG8_SA(0, 0), a2, voffA);
            PG8_WAIT_V(8); PG8_WAIT_L(0); PG8_BAR; PG8_MMA(1, 0, At, B0); PG8_MMA(1, 1, At, B1); PG8_BAR; PG8_SCHED;
            PG8_LDB(B0, 1, 0); PG8_LDB(B1, 1, 1); PG8_SCHED; PG8_LDA(At, 1, 0); PG8_STAGE(PG8_SA(0, 1), a2 + hstep, voffA);
            PG8_WAIT_V(8); PG8_WAIT_L(0); PG8_BAR; PG8_MMA(0, 0, At, B0); PG8_MMA(0, 1, At, B1); PG8_BAR; PG8_SCHED;
            PG8_LDA(At, 1, 1); PG8_STAGE(PG8_SB(1, 0), b3, voffB); PG8_STAGE(PG8_SB(1, 1), b3 + hstep, voffB); PG8_STAGE(PG8_SA(1, 0), a3, voffA);
            PG8_WAIT_V(8); PG8_WAIT_L(0); PG8_BAR; PG8_MMA(1, 0, At, B0); PG8_MMA(1, 1, At, B1); PG8_BAR; PG8_SCHED;
            } else {
            PG8_LDB(B0, 0, 0); PG8_SCHED; PG8_LDA(At, 0, 0); PG8_STAGE(PG8_SA(1, 1), a1 + hstep, voffA);
            PG8_WAIT_L(8); PG8_BAR; PG8_WAIT_L(0); PG8_MMA(0, 0, At, B0); PG8_BAR; PG8_SCHED;
            PG8_LDB(B1, 0, 1); PG8_STAGE(PG8_SB(0, 0), b2, voffB);
            PG8_BAR; PG8_WAIT_L(0); PG8_MMA(0, 1, At, B1); PG8_BAR;
            PG8_LDA(At, 0, 1); PG8_STAGE(PG8_SA(0, 0), a2, voffA);
            PG8_BAR; PG8_WAIT_L(0); PG8_MMA(1, 0, At, B0); PG8_BAR; PG8_SCHED;
            PG8_STAGE(PG8_SB(0, 1), b2 + hstep, voffB);
            PG8_WAIT_V(6); PG8_BAR; PG8_MMA(1, 1, At, B1); PG8_BAR;
            PG8_LDB(B0, 1, 0); PG8_SCHED; PG8_LDA(At, 1, 0); PG8_STAGE(PG8_SA(0, 1), a2 + hstep, voffA);
            PG8_WAIT_L(8); PG8_BAR; PG8_WAIT_L(0); PG8_MMA(0, 0, At, B0); PG8_BAR; PG8_SCHED;
            PG8_LDB(B1, 1, 1); PG8_STAGE(PG8_SB(1, 0), b3, voffB);
            PG8_BAR; PG8_WAIT_L(0); PG8_MMA(0, 1, At, B1); PG8_BAR;
            PG8_LDA(At, 1, 1); PG8_STAGE(PG8_SA(1, 0), a3, voffA);
            PG8_BAR; PG8_WAIT_L(0); PG8_MMA(1, 0, At, B0); PG8_BAR; PG8_SCHED;
            PG8_STAGE(PG8_SB(1, 1), b3 + hstep, voffB);
            PG8_WAIT_V(6); PG8_BAR; PG8_MMA(1, 1, At, B1); PG8_BAR;
            }
        }
        if constexpr (ALIGN_EPI) { if (wr == 0) PG8_BAR; }
        if constexpr (!Epi::AFTER_DRAIN) { E(acc, cur, wr, wc, fr, fq); S.done(cur); }
        if (!has_next) break;
#pragma unroll
        for (int a = 0; a < 2; ++a)
#pragma unroll
            for (int b = 0; b < 2; ++b)
#pragma unroll
                for (int m = 0; m < 4; ++m)
#pragma unroll
                    for (int n = 0; n < 2; ++n) acc[a][b][m][n] = (f32x4){0.f, 0.f, 0.f, 0.f};
        cur = nxt; cA = nA; cB = nB; ++ui;
        if constexpr (ALIGN_EPI) { if (wr == 1) PG8_BAR; }
    }
    PG8_WAIT_V(0);
    if constexpr (!ALIGN_EPI) { if (wr == 0) PG8_BAR; }
    PG8_BAR;
    if constexpr (Epi::AFTER_DRAIN) { E.fused(acc, cur, wr, wc, fr, fq, lds, wid, lane); S.done(cur); }
#undef PG8_SA
#undef PG8_SB
#undef PG8_STAGE
#undef PG8_LDA
#undef PG8_LDB
#undef PG8_MMA
#undef PG8_WAIT_V
#undef PG8_WAIT_L
#undef PG8_BAR
#undef PG8_SCHED
}
}

constexpr int BATCH = 2, SEQ = 16384, D = 1024, T = BATCH * SEQ, DEPTH = 4;
constexpr int NH = 4, DK = 64, DV = 128, RANK = 16;
constexpr int NPROJ_SRC = 3088, NPROJ = 3328;
constexpr int C_B = 0, C_C = 512, C_H = 1024, C_Q = 1536, C_K = 1792, C_V = 2048, C_G = 2560, C_GK = 3072;
constexpr int FF = 2816, NE = 8, NGU = 2 * FF;
constexpr int NCH = SEQ / 64;
constexpr int NUNIT = BATCH * NCH * NH;
constexpr int MOE_ROWS = 2 * T + NE * 256;
constexpr float ALPHA = 1.6817928305074290f;
constexpr float LN_EPS = 1e-5f, RMS_EPS = 1e-6f;
constexpr int NWAVES = 8, NTHR = 512;

constexpr size_t MiB = 1u << 20;
constexpr size_t WS_CTL = 0, CTL_ZERO_BYTES = 1 * MiB;
constexpr size_t WS_MODP = 1 * MiB;
constexpr size_t WS_MOD = 3 * MiB;
constexpr size_t WS_WIN = 4 * MiB;
constexpr size_t WS_WOUT = 30 * MiB;
constexpr size_t WS_WGU = 38 * MiB;
constexpr size_t WS_WDN = 60 * MiB;
constexpr size_t WS_MWGU = 71 * MiB;
constexpr size_t WS_MWDN = 159 * MiB;
constexpr size_t WS_U = 203 * MiB;
constexpr size_t WS_MISC = 267 * MiB;
constexpr size_t WS_R1 = 269 * MiB;
constexpr size_t WS_PROJ = WS_R1;
constexpr size_t WS_KV = WS_R1 + 208 * MiB;
constexpr size_t WS_ST = WS_R1 + 272 * MiB;
constexpr size_t WS_DEC = WS_R1 + 336 * MiB;
constexpr size_t WS_Y = WS_R1 + 337 * MiB;
constexpr size_t WS_MIX = WS_R1 + 401 * MiB;
constexpr size_t WS_H = WS_R1;
constexpr size_t WS_XS = WS_R1 + 363 * MiB;
constexpr size_t WS_YS = WS_XS;
constexpr size_t WS_END = WS_R1 + 529 * MiB;
static_assert(WS_MIX + (size_t)T * D * 4 <= WS_END && WS_XS + (size_t)MOE_ROWS * D * 2 <= WS_MIX + (size_t)T * D * 4 && WS_H + (size_t)MOE_ROWS * FF * 2 <= WS_XS, "ws map");
static_assert(WS_WIN + (size_t)4 * NPROJ * D * 2 <= WS_WOUT && WS_WGU + (size_t)2 * NGU * D * 2 <= WS_WDN && WS_WDN + (size_t)2 * D * FF * 2 <= WS_MWGU && WS_MWGU + (size_t)NE * NGU * D * 2 <= WS_MWDN && WS_MWDN + (size_t)NE * D * FF * 2 <= WS_U, "ws map 2");
constexpr size_t MS_TOKE = 0;
constexpr size_t MS_TOKW = 256 * 1024;
constexpr size_t MS_CNT = 512 * 1024;
constexpr size_t MS_ROWTOK = 528 * 1024;
constexpr size_t MS_ROWW = 800 * 1024;
constexpr size_t MS_TILEE = 1072 * 1024;
constexpr size_t MS_META = 1080 * 1024;
constexpr int CW_BAR = 4096;

constexpr int LDS_BYTES = 147456;
constexpr int MISC_OFF = LDS_BYTES - 128;

#define GAS __attribute__((address_space(1)))
#define LAS __attribute__((address_space(3)))
typedef unsigned short bf16;
typedef unsigned v4u __attribute__((ext_vector_type(4)));
typedef unsigned v2u __attribute__((ext_vector_type(2)));
typedef float f32x4 __attribute__((ext_vector_type(4)));
#define LDS_WAIT() asm volatile("s_waitcnt lgkmcnt(0)" ::: "memory")
__device__ __forceinline__ unsigned f2bf(float f) { unsigned u = __builtin_bit_cast(unsigned, f); return (u + 0x7fffu + ((u >> 16) & 1u)) >> 16; }
__device__ __forceinline__ unsigned pk2(float lo, float hi) { return f2bf(lo) | (f2bf(hi) << 16); }
__device__ __forceinline__ float bf_lo(unsigned w) { return __builtin_bit_cast(float, w << 16); }
__device__ __forceinline__ float bf_hi(unsigned w) { return __builtin_bit_cast(float, w & 0xffff0000u); }
__device__ __forceinline__ float bf1(bf16 h) { return __builtin_bit_cast(float, ((unsigned)h) << 16); }

#define XB_TMO      128
#define XB_XCNT(j)  (256  + 64 * (j))
#define XB_XSUB(j)  (1280 + 64 * (j))
#define XB_XGEN(j)  (2304 + 64 * (j))
#define XB_TOP      3328
#define XB_TOPGEN   3392
#define XCD_BAR_WORDS 3456
#define XB_SPIN_CAP (1u << 18)
__device__ __forceinline__ unsigned xb_ld(unsigned* p)              { return __hip_atomic_load(p, __ATOMIC_RELAXED, __HIP_MEMORY_SCOPE_AGENT); }
__device__ __forceinline__ unsigned xb_add(unsigned* p, unsigned v) { return __hip_atomic_fetch_add(p, v, __ATOMIC_RELAXED, __HIP_MEMORY_SCOPE_AGENT); }
__device__ __forceinline__ unsigned xb_xcc_id() { return (unsigned)__builtin_amdgcn_s_getreg((3 << 11) | 20) & 0xFu; }
#define XB_SPIN(cond, bar) do { unsigned _sp = 0; while (cond) { __builtin_amdgcn_s_sleep(1); \
    if ((++_sp & 255u) == 0u) { if (xb_ld(&(bar)[XB_TMO])) break; if (_sp > XB_SPIN_CAP) { atomicAdd(&(bar)[XB_TMO], 1u); break; } } } } while (0)
struct XcdBarrier { unsigned* bar; unsigned x; volatile LAS unsigned* st; };
__device__ __forceinline__ XcdBarrier xcd_barrier_post(unsigned* bar, volatile LAS unsigned* st) {
    XcdBarrier b; b.bar = bar; b.x = xb_xcc_id(); b.st = st;
    if (threadIdx.x == 0) (void)xb_add(&bar[XB_XCNT(b.x)], 1u);
    return b;
}
__device__ __forceinline__ void xcd_barrier_complete(unsigned* bar, unsigned x, unsigned& nloc, unsigned& nx) {
    const unsigned G = gridDim.x * gridDim.y * gridDim.z;
    unsigned sum, cnt, mine, sp = 0u;
    for (;;) {
        sum = 0u; cnt = 0u; mine = 0u;
#pragma unroll
        for (unsigned j = 0; j < 16; ++j) { const unsigned c = xb_ld(&bar[XB_XCNT(j)]); sum += c; cnt += (c > 0u) ? 1u : 0u; mine = (j == x) ? c : mine; }
        if (sum == G) break;
        __builtin_amdgcn_s_sleep(1);
        if ((++sp & 255u) == 0u) { if (xb_ld(&bar[XB_TMO])) break; if (sp > XB_SPIN_CAP) { atomicAdd(&bar[XB_TMO], 1u); break; } }
    }
    nloc = mine > 0u ? mine : 1u; nx = cnt > 0u ? cnt : 1u;
}
__device__ __forceinline__ void xcd_barrier(const XcdBarrier& b) {
    asm volatile("s_waitcnt vmcnt(0)" ::: "memory");
    __syncthreads();
    if (threadIdx.x == 0) {
        unsigned* bar = b.bar;
        __builtin_amdgcn_s_waitcnt(0);
        unsigned nloc = b.st[0], nx = b.st[1];
        if (nloc == 0u) { xcd_barrier_complete(bar, b.x, nloc, nx); b.st[0] = nloc; b.st[1] = nx; }
        const unsigned old = xb_add(&bar[XB_XSUB(b.x)], 1u);
        const unsigned gen = old / nloc;
        if (old + 1u == (gen + 1u) * nloc) {
            __builtin_amdgcn_fence(__ATOMIC_RELEASE, "agent");
            asm volatile("s_waitcnt vmcnt(0)" ::: "memory");
            const unsigned og = xb_add(&bar[XB_TOP], 1u);
            const unsigned tg = og / nx;
            if (og + 1u == (tg + 1u) * nx) xb_add(&bar[XB_TOPGEN], 1u);
            else XB_SPIN(xb_ld(&bar[XB_TOPGEN]) == tg, bar);
            __builtin_amdgcn_fence(__ATOMIC_ACQUIRE, "agent");
            xb_add(&bar[XB_XGEN(b.x)], 1u);
            asm volatile("s_waitcnt vmcnt(0)" ::: "memory");
        } else {
            XB_SPIN(xb_ld(&bar[XB_XGEN(b.x)]) == gen, bar);
            __builtin_amdgcn_fence(__ATOMIC_ACQUIRE, "agent");
            asm volatile("s_waitcnt vmcnt(0)" ::: "memory");
        }
    }
    __syncthreads();
}

struct Args { const float* in[21]; float* out; unsigned char* ws; int ph_lo, ph_hi, li, pad; };
typedef const Args __attribute__((address_space(4)))* KA;
__device__ __forceinline__ KA kargs() { KA p = (KA)__builtin_amdgcn_kernarg_segment_ptr(); asm volatile("" : "+s"(p)); return p; }
enum { I_X = 0, I_C, I_ADAW, I_ADAB, I_WIN, I_CONVW, I_GKW2, I_GKB, I_NORMW, I_WOUT, I_LN1G, I_LN1B, I_LN2G, I_LN2B, I_FG, I_FU, I_FD, I_RW, I_MG, I_MU, I_MD };

#define OPAQUE_IDS int tid = threadIdx.x; asm volatile("" : "+v"(tid)); int bid = blockIdx.x; asm volatile("" : "+s"(bid)); (void)tid; (void)bid
__device__ __forceinline__ float wave_sum(float v) {
#pragma unroll
    for (int o = 1; o < 64; o <<= 1) v += __shfl_xor(v, o);
    return v;
}
__device__ __forceinline__ float silu_f(float x) { return x / (1.f + __expf(-x)); }

__device__ __forceinline__ void transpose_item(const float* W, int ldw, int K, bf16* WT, int drow0, int k0, int n0, LAS float* scr, int lane) {
#pragma unroll 8
    for (int i = 0; i < 32; ++i) { const int kk = 2 * i + (lane >> 5); scr[kk * 33 + (lane & 31)] = W[(size_t)(k0 + kk) * ldw + n0 + (lane & 31)]; }
    LDS_WAIT(); asm volatile("" ::: "memory");
    const int c = lane & 7;
#pragma unroll
    for (int j = 0; j < 4; ++j) { const int n = (lane >> 3) + 8 * j; const LAS float* s = scr + (8 * c) * 33 + n;
        v4u o; o.x = pk2(s[0 * 33], s[1 * 33]); o.y = pk2(s[2 * 33], s[3 * 33]); o.z = pk2(s[4 * 33], s[5 * 33]); o.w = pk2(s[6 * 33], s[7 * 33]);
        *(GAS v4u*)(WT + (size_t)(drow0 + n) * K + k0 + 8 * c) = o; }
    LDS_WAIT(); asm volatile("" ::: "memory");
}
__device__ __forceinline__ int gu_row(int f, int up) { return (f >> 7) * 256 + up * 128 + (f & 127); }

__device__ __forceinline__ void phase_p0(KA a, LAS unsigned char* lds, int gw, int NGW, int wave, int lane) {
    unsigned char* ws = a->ws;
    LAS float* scr = (LAS float*)(lds + wave * 16384);
    for (int it = gw; it < 768; it += NGW) {
        const int l = it / 192, rem = it % 192, nb = rem >> 3, ks = rem & 7;
        const float* w = a->in[I_ADAW] + ((size_t)l * D + ks * 128) * 6144 + nb * 256 + lane * 4;
        const float* c0p = a->in[I_C] + ks * 128; const float* c1p = c0p + D;
        f32x4 a0 = {0.f, 0.f, 0.f, 0.f}, a1 = {0.f, 0.f, 0.f, 0.f};
#pragma unroll 8
        for (int k = 0; k < 128; ++k) { const f32x4 wv = *(const f32x4*)(w + (size_t)k * 6144); const float s0 = silu_f(c0p[k]), s1 = silu_f(c1p[k]); a0 += wv * s0; a1 += wv * s1; }
        float* mp = (float*)(ws + WS_MODP) + ((size_t)(l * 8 + ks) * 2) * 6144 + nb * 256 + lane * 4;
        *(f32x4*)mp = a0; *(f32x4*)(mp + 6144) = a1;
    }
    for (int it = gw; it < 64; it += NGW) {
        const int l = it >> 4, kb = it & 15, k = kb * 64 + lane;
        const float* gp = a->in[I_WIN] + ((size_t)l * D + k) * NPROJ_SRC + 3072;
        const f32x4 g0 = *(const f32x4*)gp, g1 = *(const f32x4*)(gp + 4), g2 = *(const f32x4*)(gp + 8), g3 = *(const f32x4*)(gp + 12);
        const float* w2 = a->in[I_GKW2] + (size_t)l * RANK * 256;
        bf16* wt = (bf16*)(ws + WS_WIN) + ((size_t)l * NPROJ + 3072) * D + k;
        for (int n = 0; n < 256; ++n) {
            float s = g0[0] * w2[n] + g0[1] * w2[256 + n] + g0[2] * w2[512 + n] + g0[3] * w2[768 + n];
            s += g1[0] * w2[1024 + n] + g1[1] * w2[1280 + n] + g1[2] * w2[1536 + n] + g1[3] * w2[1792 + n];
            s += g2[0] * w2[2048 + n] + g2[1] * w2[2304 + n] + g2[2] * w2[2560 + n] + g2[3] * w2[2816 + n];
            s += g3[0] * w2[3072 + n] + g3[1] * w2[3328 + n] + g3[2] * w2[3584 + n] + g3[3] * w2[3840 + n];
            wt[(size_t)n * D] = (bf16)f2bf(s);
        }
    }
    constexpr int I_IN = 16 * 96, I_OUT = 16 * 32, I_G = 16 * 88, I_D = 44 * 32;
    constexpr int PER_L = I_IN + I_OUT, PER_J = 2 * I_G + I_D, NIT = 4 * PER_L + 2 * PER_J;
    for (int it = gw; it < NIT; it += NGW) {
        int r = it;
        if (r < 4 * PER_L) { const int l = r / PER_L; r -= l * PER_L;
            if (r < I_IN) { const int kb = r / 96, nb = r % 96; transpose_item(a->in[I_WIN] + (size_t)l * D * NPROJ_SRC, NPROJ_SRC, D, (bf16*)(ws + WS_WIN) + (size_t)l * NPROJ * D, nb * 32, kb * 64, nb * 32, scr, lane); }
            else { r -= I_IN; const int kb = r / 32, nb = r % 32; transpose_item(a->in[I_WOUT] + (size_t)l * D * D, D, D, (bf16*)(ws + WS_WOUT) + (size_t)l * D * D, nb * 32, kb * 64, nb * 32, scr, lane); }
            continue; }
        r -= 4 * PER_L; const int j = r / PER_J; r -= j * PER_J;
        if (r < 2 * I_G) { const int up = r / I_G; r -= up * I_G; const int kb = r / 88, nb = r % 88;
            transpose_item(a->in[up ? I_FU : I_FG] + (size_t)j * D * FF, FF, D, (bf16*)(ws + WS_WGU) + (size_t)j * NGU * D, gu_row(nb * 32, up), kb * 64, nb * 32, scr, lane); }
        else { r -= 2 * I_G; const int kb = r / 32, nb = r % 32;
            transpose_item(a->in[I_FD] + (size_t)j * FF * D, D, FF, (bf16*)(ws + WS_WDN) + (size_t)j * D * FF, nb * 32, kb * 64, nb * 32, scr, lane); }
    }
}
__device__ __forceinline__ void moe_weights(KA a, int j, LAS unsigned char* lds, int gw, int NGW, int wave, int lane) {
    unsigned char* ws = a->ws;
    LAS float* scr = (LAS float*)(lds + wave * 16384);
    constexpr int I_G = 16 * 88, I_D = 44 * 32, PER_E = 2 * I_G + I_D;
    for (int it = gw; it < NE * PER_E; it += NGW) {
        const int e = it / PER_E; int r = it - e * PER_E;
        if (r < 2 * I_G) { const int up = r / I_G; r -= up * I_G; const int kb = r / 88, nb = r % 88;
            transpose_item(a->in[up ? I_MU : I_MG] + ((size_t)j * NE + e) * D * FF, FF, D, (bf16*)(ws + WS_MWGU) + (size_t)e * NGU * D, gu_row(nb * 32, up), kb * 64, nb * 32, scr, lane); }
        else { r -= 2 * I_G; const int kb = r / 32, nb = r % 32;
            transpose_item(a->in[I_MD] + ((size_t)j * NE + e) * FF * D, D, FF, (bf16*)(ws + WS_MWDN) + (size_t)e * D * FF, nb * 32, kb * 64, nb * 32, scr, lane); }
    }
}

__device__ __forceinline__ void phase_p1(KA a, LAS unsigned char* lds, int gw, int NGW, int lane) {
    OPAQUE_IDS;
    unsigned char* ws = a->ws;
    const float* modp = (const float*)(ws + WS_MODP); float* mod = (float*)(ws + WS_MOD);
    for (int i = bid * NTHR + tid; i < 4 * 2 * 6144; i += gridDim.x * NTHR) {
        const int l = i / 12288, r = i % 12288, b = r / 6144, n = r % 6144; float s = a->in[I_ADAB][l * 6144 + n];
#pragma unroll
        for (int ks = 0; ks < 8; ++ks) s += modp[((size_t)(l * 8 + ks) * 2 + b) * 6144 + n];
        mod[i] = s; }
    LAS float* mL = (LAS float*)lds;
    for (int i = tid; i < 4096; i += NTHR) { const int b = i >> 11, n = i & 2047; float s = a->in[I_ADAB][n];
#pragma unroll
        for (int ks = 0; ks < 8; ++ks) s += modp[((size_t)ks * 2 + b) * 6144 + n];
        mL[i] = s; }
    __syncthreads();
    const float* x = a->in[I_X]; bf16* U = (bf16*)(ws + WS_U);
    for (int m = gw; m < T; m += NGW) { const int b = m >= SEQ; const LAS float* sh = mL + b * 2048; const LAS float* sc = sh + 1024;
        const f32x4* xr = (const f32x4*)(x + (size_t)m * D) + lane; v2u* o8 = (v2u*)(U + (size_t)m * D) + lane;
#pragma unroll
        for (int j = 0; j < 4; ++j) { const f32x4 v = xr[64 * j]; const int c = 256 * j + 4 * lane;
            v2u w; w.x = pk2(v[0] * (1.f + sc[c]) + sh[c], v[1] * (1.f + sc[c + 1]) + sh[c + 1]); w.y = pk2(v[2] * (1.f + sc[c + 2]) + sh[c + 2], v[3] * (1.f + sc[c + 3]) + sh[c + 3]); o8[64 * j] = w; } }
    __syncthreads();
}

template <int SRC> __device__ __forceinline__ void phase_ln(KA a, const float* xin, const float* modl, int gate_off, const float* lng, const float* lnb, int nsh_off  , const float* modn, int gw, int NGW, int lane) {
    unsigned char* ws = a->ws; float* xout = a->out; bf16* U = (bf16*)(ws + WS_U);
    for (int m = gw; m < T; m += NGW) { const int b = m >= SEQ;
        const float* gate = modl + (size_t)b * 6144 + gate_off;
        f32x4 v[4]; float s = 0.f;
#pragma unroll
        for (int j = 0; j < 4; ++j) { const int c = 256 * j + 4 * lane; const f32x4 xv = *(const f32x4*)(xin + (size_t)m * D + c); const f32x4 gv = *(const f32x4*)(gate + c); f32x4 sv;
            if (SRC == 0) sv = *(const f32x4*)((const float*)(ws + WS_MIX) + (size_t)m * D + c);
            else { const v2u p0 = *(const v2u*)((const bf16*)(ws + WS_YS) + (size_t)m * 2 * D + c), p1 = *(const v2u*)((const bf16*)(ws + WS_YS) + (size_t)m * 2 * D + D + c);
                sv = (f32x4){bf_lo(p0.x) + bf_lo(p1.x), bf_hi(p0.x) + bf_hi(p1.x), bf_lo(p0.y) + bf_lo(p1.y), bf_hi(p0.y) + bf_hi(p1.y)}; }
            v[j] = xv * ALPHA + (gv + 1.f) * sv; s += (v[j][0] + v[j][1]) + (v[j][2] + v[j][3]); }
        const float mean = wave_sum(s) * (1.f / D); float s2 = 0.f;
#pragma unroll
        for (int j = 0; j < 4; ++j) { v[j] = v[j] - mean; s2 += (v[j][0] * v[j][0] + v[j][1] * v[j][1]) + (v[j][2] * v[j][2] + v[j][3] * v[j][3]); }
        const float rstd = 1.f / sqrtf(wave_sum(s2) * (1.f / D) + LN_EPS);
#pragma unroll
        for (int j = 0; j < 4; ++j) { const int c = 256 * j + 4 * lane; const f32x4 o = v[j] * rstd * *(const f32x4*)(lng + c) + *(const f32x4*)(lnb + c);
            *(f32x4*)(xout + (size_t)m * D + c) = o;
            if (nsh_off >= 0) { const f32x4 sh = *(const f32x4*)(modn + (size_t)b * 6144 + nsh_off + c), sc = *(const f32x4*)(modn + (size_t)b * 6144 + nsh_off + 1024 + c);
                const f32x4 uu = o * (sc + 1.f) + sh; v2u w; w.x = pk2(uu[0], uu[1]); w.y = pk2(uu[2], uu[3]); *(v2u*)(U + (size_t)m * D + c) = w; } }
    }
}

__device__ __forceinline__ float logsig16(float z) { const float ls = fminf(z, 0.f) - __logf(1.f + __expf(-fabsf(z))); return fmaxf(ls * (1.f / 16.f), -1.f); }
__device__ __forceinline__ void phase_conv(KA a, int l) {
    OPAQUE_IDS;
    unsigned char* ws = a->ws; const bf16* P = (const bf16*)(ws + WS_PROJ); bf16* Y = (bf16*)(ws + WS_Y); const float* cw = a->in[I_CONVW] + (size_t)l * 3 * 512;
    for (int i = bid * NTHR + tid; i < T * 64; i += gridDim.x * NTHR) { const int t = i >> 6, c8 = (i & 63) * 8, ts = t & (SEQ - 1);
        const bf16* pr = P + (size_t)t * NPROJ;
        float z[3][8];
#pragma unroll
        for (int j = 0; j < 3; ++j) { const int back = 2 - j;
            if (ts >= back) { const v4u cc = *(const v4u*)(pr - (size_t)back * NPROJ + C_C + c8), hh = *(const v4u*)(pr - (size_t)back * NPROJ + C_H + c8);
                z[j][0] = bf_lo(cc.x) * bf_lo(hh.x); z[j][1] = bf_hi(cc.x) * bf_hi(hh.x); z[j][2] = bf_lo(cc.y) * bf_lo(hh.y); z[j][3] = bf_hi(cc.y) * bf_hi(hh.y);
                z[j][4] = bf_lo(cc.z) * bf_lo(hh.z); z[j][5] = bf_hi(cc.z) * bf_hi(hh.z); z[j][6] = bf_lo(cc.w) * bf_lo(hh.w); z[j][7] = bf_hi(cc.w) * bf_hi(hh.w); }
            else {
#pragma unroll
                for (int e = 0; e < 8; ++e) z[j][e] = 0.f; } }
        const v4u bb = *(const v4u*)(pr + C_B + c8);
        const float bv[8] = {bf_lo(bb.x), bf_hi(bb.x), bf_lo(bb.y), bf_hi(bb.y), bf_lo(bb.z), bf_hi(bb.z), bf_lo(bb.w), bf_hi(bb.w)};
        float o[8];
#pragma unroll
        for (int e = 0; e < 8; ++e) o[e] = bv[e] * (cw[c8 + e] * z[0][e] + cw[512 + c8 + e] * z[1][e] + cw[1024 + c8 + e] * z[2][e]);
        v4u w; w.x = pk2(o[0], o[1]); w.y = pk2(o[2], o[3]); w.z = pk2(o[4], o[5]); w.w = pk2(o[6], o[7]);
        *(v4u*)(Y + (size_t)t * D + c8) = w; }
}
__device__ __forceinline__ void unpack8(const v4u p, float (&f)[8]) { f[0] = bf_lo(p.x); f[1] = bf_hi(p.x); f[2] = bf_lo(p.y); f[3] = bf_hi(p.y); f[4] = bf_lo(p.z); f[5] = bf_hi(p.z); f[6] = bf_lo(p.w); f[7] = bf_hi(p.w); }
__device__ __forceinline__ void phase_gla_a(KA a, int l, LAS unsigned char* lds) {
    OPAQUE_IDS;
    unsigned char* ws = a->ws; const bf16* P = (const bf16*)(ws + WS_PROJ);
    LAS float* kL = (LAS float*)lds;
    LAS float* vL = kL + 64 * 65;
    LAS float* bL = vL + 64 * 128;
    const float* gkb = a->in[I_GKB] + (size_t)l * 256;
    float* KV = (float*)(ws + WS_KV); float* DEC = (float*)(ws + WS_DEC);
    for (int unit = bid; unit < NUNIT; unit += gridDim.x) {
        const int h = unit & 3, cn = unit >> 2; const size_t row0 = (size_t)cn * 64;
        const int j = tid >> 3, d8 = (tid & 7) * 8;
        { const bf16* pr = P + (row0 + j) * NPROJ; float f[8], g[8];
          unpack8(*(const v4u*)(pr + C_K + h * 64 + d8), f); unpack8(*(const v4u*)(pr + C_GK + h * 64 + d8), g);
#pragma unroll
          for (int e = 0; e < 8; ++e) { kL[j * 65 + d8 + e] = f[e]; bL[j * 64 + d8 + e] = logsig16(g[e] + gkb[h * 64 + d8 + e]); }
          const int c16 = (tid & 7) * 16;
          unpack8(*(const v4u*)(pr + C_V + h * 128 + c16), f); unpack8(*(const v4u*)(pr + C_V + h * 128 + c16 + 8), g);
#pragma unroll
          for (int e = 0; e < 8; ++e) { vL[j * 128 + c16 + e] = f[e]; vL[j * 128 + c16 + 8 + e] = g[e]; } }
        __syncthreads();
        if (tid < 64) { float s = 0.f; for (int jj = 0; jj < 64; ++jj) { s += bL[jj * 64 + tid]; bL[jj * 64 + tid] = s; } }
        __syncthreads();
#pragma unroll
        for (int e = 0; e < 8; ++e) kL[j * 65 + d8 + e] *= __expf(bL[63 * 64 + d8 + e] - bL[j * 64 + d8 + e]);
        if (tid < 64) DEC[(size_t)unit * 64 + tid] = __expf(bL[63 * 64 + tid]);
        __syncthreads();
        { const int v = tid & 127, dg = tid >> 7; float acc[16];
#pragma unroll
          for (int dd = 0; dd < 16; ++dd) acc[dd] = 0.f;
          for (int jj = 0; jj < 64; ++jj) { const float vv = vL[jj * 128 + v];
#pragma unroll
              for (int dd = 0; dd < 16; ++dd) acc[dd] += kL[jj * 65 + dg * 16 + dd] * vv; }
#pragma unroll
          for (int dd = 0; dd < 16; ++dd) KV[((size_t)unit * 64 + dg * 16 + dd) * 128 + v] = acc[dd]; }
        __syncthreads();
    }
}
__device__ __forceinline__ void phase_scan(KA a) {
    OPAQUE_IDS;
    unsigned char* ws = a->ws; const float* KV = (const float*)(ws + WS_KV); const float* DEC = (const float*)(ws + WS_DEC); float* ST = (float*)(ws + WS_ST);
    if (tid >= 256) return;
    for (int e = bid * 256 + tid; e < BATCH * NH * DK * DV; e += gridDim.x * 256) {
        const int v = e & 127, d = (e >> 7) & 63, h = (e >> 13) & 3, b = e >> 15; float S = 0.f;
#pragma unroll 8
        for (int n = 0; n < NCH; ++n) { const size_t unit = (size_t)(b * NCH + n) * 4 + h; const size_t idx = (unit * 64 + d) * 128 + v;
            const float kvv = KV[idx], dc = DEC[unit * 64 + d]; ST[idx] = S; S = dc * S + kvv; }
    }
}
__device__ __forceinline__ void phase_gla_b(KA a, int l, LAS unsigned char* lds) {
    OPAQUE_IDS;
    unsigned char* ws = a->ws; const bf16* P = (const bf16*)(ws + WS_PROJ); bf16* Y = (bf16*)(ws + WS_Y); const int lane = tid & 63, wave = tid >> 6;
    LAS float* qL = (LAS float*)lds;
    LAS float* kL = qL + 64 * 64;
    LAS float* vL = kL + 64 * 65;
    LAS float* bL = vL + 64 * 128;
    LAS float* SL = bL + 64 * 65;
    LAS float* red = SL + 64 * 128;
    const float* gkb = a->in[I_GKB] + (size_t)l * 256; const float* nw = a->in[I_NORMW] + (size_t)l * 128;
    const float* ST = (const float*)(ws + WS_ST);
    for (int unit = bid; unit < NUNIT; unit += gridDim.x) {
        const int h = unit & 3, cn = unit >> 2; const size_t row0 = (size_t)cn * 64;
        const int j = tid >> 3, d8 = (tid & 7) * 8;
        { const bf16* pr = P + (row0 + j) * NPROJ; float f[8], g[8], q[8];
          unpack8(*(const v4u*)(pr + C_Q + h * 64 + d8), q); unpack8(*(const v4u*)(pr + C_K + h * 64 + d8), f); unpack8(*(const v4u*)(pr + C_GK + h * 64 + d8), g);
#pragma unroll
          for (int e = 0; e < 8; ++e) { qL[j * 64 + d8 + e] = q[e]; kL[j * 65 + d8 + e] = f[e]; bL[j * 64 + d8 + e] = logsig16(g[e] + gkb[h * 64 + d8 + e]); }
          const int c16 = (tid & 7) * 16;
          unpack8(*(const v4u*)(pr + C_V + h * 128 + c16), f); unpack8(*(const v4u*)(pr + C_V + h * 128 + c16 + 8), g);
#pragma unroll
          for (int e = 0; e < 8; ++e) { vL[j * 128 + c16 + e] = f[e]; vL[j * 128 + c16 + 8 + e] = g[e]; }
          const f32x4* sp = (const f32x4*)(ST + (size_t)unit * 8192);
#pragma unroll
          for (int i = 0; i < 4; ++i) *(LAS f32x4*)(SL + (tid + i * 512) * 4) = sp[tid + i * 512]; }
        __syncthreads();
        if (tid < 64) { float s = 0.f; for (int jj = 0; jj < 64; ++jj) { s += bL[jj * 64 + tid]; bL[jj * 64 + tid] = s; } }
        __syncthreads();
#pragma unroll
        for (int e = 0; e < 8; ++e) { const float bb = bL[j * 64 + d8 + e]; qL[j * 64 + d8 + e] *= 0.125f * __expf(bb); kL[j * 65 + d8 + e] *= __expf(-bb); }
        __syncthreads();
        { const int jj = tid & 63, ig = tid >> 6; float s[8];
#pragma unroll
          for (int ii = 0; ii < 8; ++ii) s[ii] = 0.f;
          for (int d = 0; d < 64; ++d) { const float kk = kL[jj * 65 + d];
#pragma unroll
              for (int ii = 0; ii < 8; ++ii) s[ii] += qL[(ig * 8 + ii) * 64 + d] * kk; }
          __syncthreads();
#pragma unroll
          for (int ii = 0; ii < 8; ++ii) bL[(ig * 8 + ii) * 65 + jj] = (jj <= ig * 8 + ii) ? s[ii] : 0.f; }
        __syncthreads();
        { const int v = tid & 127, ig = tid >> 7; float acc[16];
#pragma unroll
          for (int ii = 0; ii < 16; ++ii) acc[ii] = 0.f;
          for (int jj = 0; jj < 64; ++jj) { const float vv = vL[jj * 128 + v];
#pragma unroll
              for (int ii = 0; ii < 16; ++ii) acc[ii] += bL[(ig * 16 + ii) * 65 + jj] * vv; }
          for (int d = 0; d < 64; ++d) { const float sv = SL[d * 128 + v];
#pragma unroll
              for (int ii = 0; ii < 16; ++ii) acc[ii] += qL[(ig * 16 + ii) * 64 + d] * sv; }
#pragma unroll
          for (int ii = 0; ii < 16; ++ii) { const float ss = wave_sum(acc[ii] * acc[ii]); if (lane == 0) red[wave * 16 + ii] = ss; }
          __syncthreads();
          const float nwv = nw[v];
#pragma unroll
          for (int ii = 0; ii < 16; ++ii) { const float ms = (red[(2 * ig) * 16 + ii] + red[(2 * ig + 1) * 16 + ii]) * (1.f / 128.f);
              const size_t t = row0 + ig * 16 + ii; const float gg = bf1(P[t * NPROJ + C_G + h * 128 + v]);
              const float o = acc[ii] * (1.f / sqrtf(ms + RMS_EPS)) * nwv * silu_f(gg);
              Y[t * D + 512 + h * 128 + v] = (bf16)f2bf(o); } }
        __syncthreads();
    }
}


typedef short s16x4 __attribute__((ext_vector_type(4)));
typedef short bf16x8 __attribute__((ext_vector_type(8)));
constexpr int GLA_WAVE_LDS = 17920;
__device__ __forceinline__ v4u ldg16(const char* ubase, unsigned off) { return *(const v4u*)(ubase + off); }
__device__ __forceinline__ s16x4 tr16(LAS const unsigned char* p) { return __builtin_bit_cast(s16x4, __builtin_amdgcn_ds_read_tr16_b64_v4i16((LAS s16x4*)p)); }
__device__ __forceinline__ bf16x8 cat8(s16x4 lo, s16x4 hi) { return __builtin_shufflevector(lo, hi, 0, 1, 2, 3, 4, 5, 6, 7); }
__device__ __forceinline__ bf16x8 pack8(const float (&f)[8]) { v4u w; w.x = pk2(f[0], f[1]); w.y = pk2(f[2], f[3]); w.z = pk2(f[4], f[5]); w.w = pk2(f[6], f[7]); return __builtin_bit_cast(bf16x8, w); }
__device__ __forceinline__ void gla_gk_store(const bf16* P, size_t row0, int h, const float* gkb, LAS float* bw, int lane) {
    v4u graw[8]; const char* Pg = (const char*)(P + row0 * NPROJ + C_GK + h * 64); const unsigned lo8 = (unsigned)((lane >> 3) * (NPROJ * 2) + (lane & 7) * 16);
#pragma unroll
    for (int q = 0; q < 8; ++q) graw[q] = ldg16(Pg, lo8 + (unsigned)(q * 8 * NPROJ * 2));
    float gb[8];
#pragma unroll
    for (int e = 0; e < 8; ++e) gb[e] = gkb[h * 64 + (lane & 7) * 8 + e];
#pragma unroll
    for (int q = 0; q < 8; ++q) { const int c = q * 64 + lane, j = c >> 3, d8 = (c & 7) * 8, x = (j & 15) << 2; float f[8]; unpack8(graw[q], f);
        f32x4 w0, w1;
#pragma unroll
        for (int e = 0; e < 4; ++e) { w0[e] = logsig16(f[e] + gb[e]); w1[e] = logsig16(f[4 + e] + gb[4 + e]); }
        *(LAS f32x4*)(bw + j * 64 + (d8 ^ x)) = w0; *(LAS f32x4*)(bw + j * 64 + ((d8 + 4) ^ x)) = w1; }
    LDS_WAIT();
}
__device__ __forceinline__ float gla_colsum(LAS float* bw, int lane) {
    float s = 0.f;
#pragma unroll
    for (int j = 0; j < 64; ++j) { const int idx = j * 64 + (lane ^ ((j & 15) << 2)); s += bw[idx]; bw[idx] = s; }
    LDS_WAIT();
    return s;
}
__device__ __forceinline__ void gla_a_unit(KA a, int l, int unit, LAS unsigned char* wl, int lane) {
    asm volatile("" : "+v"(lane));
    unsigned char* ws = a->ws; const bf16* P = (const bf16*)(ws + WS_PROJ);
    const int h = unit & 3, cn = unit >> 2, i16 = lane & 15, g = lane >> 4, tq = i16 >> 2, tp = i16 & 3; const size_t row0 = (size_t)cn * 64;
    LAS float* bw = (LAS float*)wl;
    gla_gk_store(P, row0, h, a->in[I_GKB] + (size_t)l * 256, bw, lane);
    v4u kr[4][2];
#pragma unroll
    for (int mt = 0; mt < 4; ++mt)
#pragma unroll
        for (int ks = 0; ks < 2; ++ks) kr[mt][ks] = ldg16((const char*)(P + row0 * NPROJ + C_K + h * 64), (unsigned)(i16 * (NPROJ * 2) + g * 16) + (unsigned)(mt * 16 * NPROJ * 2 + ks * 64));
    const float sl = gla_colsum(bw, lane);
    ((float*)(ws + WS_DEC))[(size_t)unit * 64 + lane] = __expf(sl);
    v4u ko[4][2];
#pragma unroll
    for (int ks = 0; ks < 2; ++ks) { const int d0 = 32 * ks + 8 * g;
        const f32x4 l0 = *(const LAS f32x4*)(bw + 63 * 64 + (d0 ^ 60)), l1 = *(const LAS f32x4*)(bw + 63 * 64 + ((d0 + 4) ^ 60));
#pragma unroll
        for (int mt = 0; mt < 4; ++mt) { const int j = 16 * mt + i16, x = i16 << 2;
            const f32x4 b0 = *(const LAS f32x4*)(bw + j * 64 + (d0 ^ x)), b1 = *(const LAS f32x4*)(bw + j * 64 + ((d0 + 4) ^ x));
            float k[8], o[8]; unpack8(kr[mt][ks], k);
#pragma unroll
            for (int e = 0; e < 4; ++e) { o[e] = k[e] * __expf(l0[e] - b0[e]); o[4 + e] = k[4 + e] * __expf(l1[e] - b1[e]); }
            ko[mt][ks] = __builtin_bit_cast(v4u, pack8(o)); } }
    LDS_WAIT();
    LAS unsigned char* kimg = wl;
    LAS unsigned char* vimg = wl + 8704;
#pragma unroll
    for (int mt = 0; mt < 4; ++mt)
#pragma unroll
        for (int ks = 0; ks < 2; ++ks) { LAS unsigned char* p = kimg + (16 * mt + i16) * 136 + (32 * ks + 8 * g) * 2;
            *(LAS v2u*)p = (v2u){ko[mt][ks].x, ko[mt][ks].y}; *(LAS v2u*)(p + 8) = (v2u){ko[mt][ks].z, ko[mt][ks].w}; }
    float* KVT = (float*)(ws + WS_KV);
    bf16x8 kA[4][2];
#pragma unroll
    for (int hv = 0; hv < 2; ++hv) {
        v4u vr[8];
#pragma unroll
        for (int q = 0; q < 8; ++q) vr[q] = ldg16((const char*)(P + row0 * NPROJ + C_V + h * 128 + 64 * hv), (unsigned)((lane >> 3) * (NPROJ * 2) + (lane & 7) * 16) + (unsigned)(q * 8 * NPROJ * 2));
#pragma unroll
        for (int q = 0; q < 8; ++q) { const int c = q * 64 + lane, j = c >> 3, c8 = (c & 7) * 8; LAS unsigned char* p = vimg + j * 136 + c8 * 2;
            *(LAS v2u*)p = (v2u){vr[q].x, vr[q].y}; *(LAS v2u*)(p + 8) = (v2u){vr[q].z, vr[q].w}; }
        LDS_WAIT();
        if (hv == 0) {
#pragma unroll
            for (int dt = 0; dt < 4; ++dt)
#pragma unroll
                for (int ks = 0; ks < 2; ++ks) { LAS const unsigned char* p = kimg + (32 * ks + 8 * g + tq) * 136 + (16 * dt + 4 * tp) * 2; kA[dt][ks] = cat8(tr16(p), tr16(p + 4 * 136)); } }
#pragma unroll
        for (int vt = 0; vt < 4; ++vt) {
            bf16x8 vB[2];
#pragma unroll
            for (int ks = 0; ks < 2; ++ks) { LAS const unsigned char* p = vimg + (32 * ks + 8 * g + tq) * 136 + (16 * vt + 4 * tp) * 2; vB[ks] = cat8(tr16(p), tr16(p + 4 * 136)); }
#pragma unroll
            for (int dt = 0; dt < 4; ++dt) { f32x4 acc = {0.f, 0.f, 0.f, 0.f};
                acc = __builtin_amdgcn_mfma_f32_16x16x32_bf16(kA[dt][0], vB[0], acc, 0, 0, 0); acc = __builtin_amdgcn_mfma_f32_16x16x32_bf16(kA[dt][1], vB[1], acc, 0, 0, 0);
                *(f32x4*)((char*)(KVT + (size_t)unit * 8192) + (unsigned)(i16 * 256 + g * 16 + (64 * hv + 16 * vt) * 256 + dt * 64)) = acc; } }
        LDS_WAIT();
    }
}
__device__ __forceinline__ void gla_b_unit(KA a, int l, int unit, LAS unsigned char* wl, int lane) {
    asm volatile("" : "+v"(lane));
    unsigned char* ws = a->ws; const bf16* P = (const bf16*)(ws + WS_PROJ); bf16* Y = (bf16*)(ws + WS_Y);
    const int h = unit & 3, cn = unit >> 2; const size_t row0 = (size_t)cn * 64;
    LAS float* bw = (LAS float*)wl;
    gla_gk_store(P, row0, h, a->in[I_GKB] + (size_t)l * 256, bw, lane);
    v4u qr[4][2], kr[4][2];
#pragma unroll
    for (int mt = 0; mt < 4; ++mt)
#pragma unroll
        for (int ks = 0; ks < 2; ++ks) { const unsigned off = (unsigned)((lane & 15) * (NPROJ * 2) + (lane >> 4) * 16) + (unsigned)(mt * 16 * NPROJ * 2 + ks * 64);
            qr[mt][ks] = ldg16((const char*)(P + row0 * NPROJ + C_Q + h * 64), off); kr[mt][ks] = ldg16((const char*)(P + row0 * NPROJ + C_K + h * 64), off); }
    (void)gla_colsum(bw, lane);
    bf16x8 qf[4][2], kf[4][2];
#pragma unroll
    for (int mt = 0; mt < 4; ++mt)
#pragma unroll
        for (int ks = 0; ks < 2; ++ks) { const int j = 16 * mt + (lane & 15), x = (lane & 15) << 2, d0 = 32 * ks + 8 * (lane >> 4);
            const f32x4 b0 = *(const LAS f32x4*)(bw + j * 64 + (d0 ^ x)), b1 = *(const LAS f32x4*)(bw + j * 64 + ((d0 + 4) ^ x));
            float q[8], k[8], qi[8], ki[8]; unpack8(qr[mt][ks], q); unpack8(kr[mt][ks], k);
#pragma unroll
            for (int e = 0; e < 4; ++e) { qi[e] = q[e] * 0.125f * __expf(b0[e]); ki[e] = k[e] * __expf(-b0[e]); qi[4 + e] = q[4 + e] * 0.125f * __expf(b1[e]); ki[4 + e] = k[4 + e] * __expf(-b1[e]); }
            qf[mt][ks] = pack8(qi); kf[mt][ks] = pack8(ki); }
    LDS_WAIT();
    LAS unsigned char* vimg = wl;
    {
        v4u vr[16];
#pragma unroll
        for (int q = 0; q < 16; ++q) vr[q] = ldg16((const char*)(P + row0 * NPROJ + C_V + h * 128), (unsigned)((lane >> 4) * (NPROJ * 2) + (lane & 15) * 16) + (unsigned)(q * 4 * NPROJ * 2));
#pragma unroll
        for (int q = 0; q < 16; ++q) { const int c = q * 64 + lane, j = c >> 4, c8 = (c & 15) * 8; *(LAS v4u*)(vimg + j * 272 + c8 * 2) = vr[q]; }
    }
    { const float* nwg = a->in[I_NORMW] + (size_t)l * 128; *(LAS v2u*)(wl + 17408 + lane * 8) = *(const v2u*)(nwg + lane * 2); }
    LDS_WAIT();
    { int l2 = lane; asm volatile("" : "+v"(l2)); lane = l2; }
    const int i16 = lane & 15, g = lane >> 4, tq = i16 >> 2, tp = i16 & 3;
    const char* ST = (const char*)((const bf16*)(ws + WS_ST) + (size_t)unit * 8192); const unsigned soff = (unsigned)(i16 * 128 + g * 16);
    bf16x8 pf[4][2];
#pragma unroll
    for (int it = 0; it < 4; ++it) {
        f32x4 sT[4];
#pragma unroll
        for (int jt = 0; jt < 4; ++jt) { f32x4 acc = {0.f, 0.f, 0.f, 0.f};
            if (jt <= it) { acc = __builtin_amdgcn_mfma_f32_16x16x32_bf16(kf[jt][0], qf[it][0], acc, 0, 0, 0); acc = __builtin_amdgcn_mfma_f32_16x16x32_bf16(kf[jt][1], qf[it][1], acc, 0, 0, 0); }
            if (jt == it) {
#pragma unroll
                for (int r = 0; r < 4; ++r) acc[r] = (4 * g + r <= i16) ? acc[r] : 0.f; }
            sT[jt] = acc; }
#pragma unroll
        for (int ks = 0; ks < 2; ++ks) { const float f[8] = {sT[2 * ks][0], sT[2 * ks][1], sT[2 * ks][2], sT[2 * ks][3], sT[2 * ks + 1][0], sT[2 * ks + 1][1], sT[2 * ks + 1][2], sT[2 * ks + 1][3]}; pf[it][ks] = pack8(f); }
    }
    f32x4 oT[8][4];
#pragma unroll
    for (int vt = 0; vt < 8; ++vt)
#pragma unroll
        for (int it = 0; it < 4; ++it) oT[vt][it] = (f32x4){0.f, 0.f, 0.f, 0.f};
#pragma unroll
    for (int ks = 0; ks < 2; ++ks)
#pragma unroll
        for (int vt = 0; vt < 8; ++vt) { LAS const unsigned char* p = vimg + (32 * ks + 4 * g + tq) * 272 + (16 * vt + 4 * tp) * 2; const bf16x8 vA = cat8(tr16(p), tr16(p + 16 * 272));
#pragma unroll
            for (int it = 0; it < 4; ++it) if (2 * ks <= it) oT[vt][it] = __builtin_amdgcn_mfma_f32_16x16x32_bf16(vA, pf[it][ks], oT[vt][it], 0, 0, 0);
            if ((vt & 3) == 3) asm volatile("" ::: "memory"); }
    asm volatile("" ::: "memory");
    bf16x8 s0[8], s1[8];
#pragma unroll
    for (int vt = 0; vt < 8; ++vt) { s0[vt] = __builtin_bit_cast(bf16x8, ldg16(ST, soff + (unsigned)(vt * 2048))); s1[vt] = __builtin_bit_cast(bf16x8, ldg16(ST, soff + (unsigned)(vt * 2048 + 64))); }
    asm volatile("" ::: "memory");
#pragma unroll
    for (int vt = 0; vt < 8; ++vt)
#pragma unroll
        for (int it = 0; it < 4; ++it) oT[vt][it] = __builtin_amdgcn_mfma_f32_16x16x32_bf16(s0[vt], qf[it][0], oT[vt][it], 0, 0, 0);
#pragma unroll
    for (int vt = 0; vt < 8; ++vt)
#pragma unroll
        for (int it = 0; it < 4; ++it) oT[vt][it] = __builtin_amdgcn_mfma_f32_16x16x32_bf16(s1[vt], qf[it][1], oT[vt][it], 0, 0, 0);
    const char* Pg0 = (const char*)(P + row0 * NPROJ + C_G + h * 128); char* Y0 = (char*)(Y + row0 * D + 512 + h * 128);
    const unsigned goff = (unsigned)(i16 * (NPROJ * 2) + g * 8), yoff = (unsigned)(i16 * (D * 2) + g * 8);
    v2u gg[8];
#pragma unroll
    for (int vt = 0; vt < 8; ++vt) gg[vt] = *(const v2u*)(Pg0 + goff + (unsigned)(vt * 32));
#pragma unroll
    for (int it = 0; it < 4; ++it) {
        float ss = 0.f;
#pragma unroll
        for (int vt = 0; vt < 8; ++vt) ss += (oT[vt][it][0] * oT[vt][it][0] + oT[vt][it][1] * oT[vt][it][1]) + (oT[vt][it][2] * oT[vt][it][2] + oT[vt][it][3] * oT[vt][it][3]);
        ss += __shfl_xor(ss, 16); ss += __shfl_xor(ss, 32);
        const float rstd = 1.f / sqrtf(ss * (1.f / 128.f) + RMS_EPS);
#pragma unroll
        for (int vt = 0; vt < 8; ++vt) { const f32x4 nv = *(const LAS f32x4*)(wl + 17408 + g * 16 + vt * 64);
            const float o0 = oT[vt][it][0] * rstd * nv[0] * silu_f(bf_lo(gg[vt].x)), o1 = oT[vt][it][1] * rstd * nv[1] * silu_f(bf_hi(gg[vt].x));
            const float o2 = oT[vt][it][2] * rstd * nv[2] * silu_f(bf_lo(gg[vt].y)), o3 = oT[vt][it][3] * rstd * nv[3] * silu_f(bf_hi(gg[vt].y));
            *(v2u*)(Y0 + yoff + (unsigned)(it * 16 * D * 2 + vt * 32)) = (v2u){pk2(o0, o1), pk2(o2, o3)}; }
        if (it < 3) {
#pragma unroll
            for (int vt = 0; vt < 8; ++vt) gg[vt] = *(const v2u*)(Pg0 + goff + (unsigned)((it + 1) * 16 * NPROJ * 2 + vt * 32)); }
        asm volatile("" ::: "memory");
    }
    LDS_WAIT();
}
__device__ __forceinline__ void phase_gla_a2(KA a, int l, LAS unsigned char* lds) {
    OPAQUE_IDS; const int lane = tid & 63, wave = __builtin_amdgcn_readfirstlane(tid >> 6);
    for (int unit = bid * NWAVES + wave; unit < NUNIT; unit += gridDim.x * NWAVES) gla_a_unit(a, l, unit, lds + wave * GLA_WAVE_LDS, lane);
}
__device__ __forceinline__ void phase_gla_b2(KA a, int l, LAS unsigned char* lds) {
    OPAQUE_IDS; const int lane = tid & 63, wave = __builtin_amdgcn_readfirstlane(tid >> 6);
    for (int unit = bid * NWAVES + wave; unit < NUNIT; unit += gridDim.x * NWAVES) gla_b_unit(a, l, unit, lds + wave * GLA_WAVE_LDS, lane);
}
__device__ __forceinline__ void phase_scan2(KA a) {
    OPAQUE_IDS;
    unsigned char* ws = a->ws; const float* KVT = (const float*)(ws + WS_KV); const float* DEC = (const float*)(ws + WS_DEC); bf16* ST = (bf16*)(ws + WS_ST);
    if (tid >= 256) return;
    for (int e = bid * 256 + tid; e < BATCH * NH * DK * DV; e += gridDim.x * 256) {
        const int d = e & 63, v = (e >> 6) & 127, h = (e >> 13) & 3, b = e >> 15; float S = 0.f;
#pragma unroll 16
        for (int n = 0; n < NCH; ++n) { const size_t unit = (size_t)(b * NCH + n) * 4 + h; const size_t idx = unit * 8192 + v * 64 + d;
            const float kvv = KVT[idx], dc = DEC[unit * 64 + d]; ST[idx] = (bf16)f2bf(S); S = dc * S + kvv; }
    }
}

__device__ __forceinline__ void phase_route1(KA a, int l, LAS unsigned char* lds) {
    OPAQUE_IDS;
    unsigned char* ws = a->ws; const int lane = tid & 63, wave = tid >> 6; const int jm = l >> 1;
    int* tok_e = (int*)(ws + WS_MISC + MS_TOKE); float* tok_w = (float*)(ws + WS_MISC + MS_TOKW); int* cnt = (int*)(ws + WS_MISC + MS_CNT); int* row_tok = (int*)(ws + WS_MISC + MS_ROWTOK);
    for (int i = bid * NTHR + tid; i < MOE_ROWS; i += gridDim.x * NTHR) row_tok[i] = -1;
    LAS float* rwL = (LAS float*)lds;
    LAS int* cL = (LAS int*)(lds + 32768);
    const float* rw = a->in[I_RW] + (size_t)jm * D * NE;
    for (int i = tid; i < D * NE; i += NTHR) rwL[i] = rw[i];
    if (tid < 8) cL[tid] = 0;
    __syncthreads();
    const float* mod = (const float*)(ws + WS_MOD) + (size_t)l * 2 * 6144;
    const int tpw = T / (int)gridDim.x;
    for (int i = wave; i < tpw; i += NWAVES) { const int t = bid * tpw + i, b = t >= SEQ;
        float lg[8];
#pragma unroll
        for (int e = 0; e < 8; ++e) lg[e] = 0.f;
#pragma unroll
        for (int jj = 0; jj < 4; ++jj) { const int c = 256 * jj + 4 * lane; const f32x4 xv = *(const f32x4*)(a->out + (size_t)t * D + c);
            const f32x4 sh = *(const f32x4*)(mod + (size_t)b * 6144 + 3072 + c), sc = *(const f32x4*)(mod + (size_t)b * 6144 + 4096 + c); const f32x4 uu = xv * (sc + 1.f) + sh;
#pragma unroll
            for (int q = 0; q < 4; ++q) { const f32x4 w0 = *(const LAS f32x4*)(rwL + (c + q) * 8), w1 = *(const LAS f32x4*)(rwL + (c + q) * 8 + 4);
                lg[0] += uu[q] * w0[0]; lg[1] += uu[q] * w0[1]; lg[2] += uu[q] * w0[2]; lg[3] += uu[q] * w0[3]; lg[4] += uu[q] * w1[0]; lg[5] += uu[q] * w1[1]; lg[6] += uu[q] * w1[2]; lg[7] += uu[q] * w1[3]; } }
#pragma unroll
        for (int e = 0; e < 8; ++e) lg[e] = wave_sum(lg[e]);
        int e0 = 0; float l0 = lg[0];
#pragma unroll
        for (int e = 1; e < 8; ++e) if (lg[e] > l0) { l0 = lg[e]; e0 = e; }
        int e1 = -1; float l1 = -3.0e38f;
#pragma unroll
        for (int e = 0; e < 8; ++e) if (e != e0 && lg[e] > l1) { l1 = lg[e]; e1 = e; }
        const float p1 = __expf(l1 - l0), w0 = 1.f / (1.f + p1), w1 = p1 * w0;
        if (lane == 0) { tok_e[t * 2] = e0; tok_e[t * 2 + 1] = e1; tok_w[t * 2] = w0; tok_w[t * 2 + 1] = w1; __hip_atomic_fetch_add(&cL[e0], 1, __ATOMIC_RELAXED, __HIP_MEMORY_SCOPE_WORKGROUP); __hip_atomic_fetch_add(&cL[e1], 1, __ATOMIC_RELAXED, __HIP_MEMORY_SCOPE_WORKGROUP); }
    }
    __syncthreads();
    if (tid < 8) cnt[bid * 8 + tid] = cL[tid];
    __syncthreads();
}
__device__ __forceinline__ void phase_route2(KA a, LAS unsigned char* lds) {
    OPAQUE_IDS;
    unsigned char* ws = a->ws; const int lane = tid & 63, wave = tid >> 6; const int G = gridDim.x;
    const int* tok_e = (const int*)(ws + WS_MISC + MS_TOKE); const float* tok_w = (const float*)(ws + WS_MISC + MS_TOKW); const int* cnt = (const int*)(ws + WS_MISC + MS_CNT);
    int* row_tok = (int*)(ws + WS_MISC + MS_ROWTOK); float* row_w = (float*)(ws + WS_MISC + MS_ROWW); int* tile_e = (int*)(ws + WS_MISC + MS_TILEE); int* meta = (int*)(ws + WS_MISC + MS_META);
    LAS int* baseL = (LAS int*)lds;
    LAS int* segL = baseL + 16;
    LAS int* totL = baseL + 32;
    LAS int* eL = baseL + 64;
    LAS int* posL = baseL + 64 + 512;
    if (tid < 8) { int tot = 0, bef = 0; for (int w = 0; w < G; ++w) { const int c = cnt[w * 8 + tid]; tot += c; if (w < (int)bid) bef += c; } baseL[tid] = bef; totL[tid] = tot; }
    __syncthreads();
    if (tid == 0) { int s = 0; for (int e = 0; e < 8; ++e) { segL[e] = s; s += (totL[e] + 255) & ~255; } segL[8] = s;
        if (bid == 0) { meta[0] = s >> 8; for (int e = 0; e < 8; ++e) for (int tt = segL[e] >> 8; tt < (segL[e + 1] >> 8); ++tt) tile_e[tt] = e; } }
    __syncthreads();
    const int tpw = T / G, npair = 2 * tpw;
    if (tid < npair) eL[tid] = tok_e[bid * npair + tid];
    __syncthreads();
    if (tid < npair) { const int e = eL[tid]; int rank = 0; for (int i = 0; i < tid; ++i) rank += (eL[i] == e) ? 1 : 0;
        const int pos = segL[e] + baseL[e] + rank; posL[tid] = pos; row_tok[pos] = bid * npair + tid; row_w[pos] = tok_w[bid * npair + tid]; }
    __syncthreads();
    const bf16* U = (const bf16*)(ws + WS_U); bf16* XS = (bf16*)(ws + WS_XS);
    for (int i = wave; i < npair; i += NWAVES) { const int t = bid * tpw + (i >> 1), pos = posL[i];
        const v4u* s = (const v4u*)(U + (size_t)t * D) + lane; v4u* d = (v4u*)(XS + (size_t)pos * D) + lane; d[0] = s[0]; d[64] = s[64]; }
    __syncthreads();
}

constexpr int PH_PER_LAYER = 11, N_PHASES = 2 + DEPTH * PH_PER_LAYER;
#define IN(k) (!MK_MULTI || (lo <= (k) && (k) < hi))
#define SEAM(k) do { if (!MK_MULTI && (k) + 1 < N_PHASES) { XcdBarrier bb_ = bar; asm volatile("" : "+s"(bb_.bar), "+s"(bb_.x)); xcd_barrier(bb_); } } while (0)
#define WAVE_IDS int tid = threadIdx.x; asm volatile("" : "+v"(tid)); const int lane = tid & 63, wave = __builtin_amdgcn_readfirstlane(tid >> 6), gw = blockIdx.x * NWAVES + wave, NGW = G * NWAVES; (void)lane; (void)gw; (void)NGW;

template <int l> __device__ __forceinline__ void layer_body(LAS unsigned char* lds, const XcdBarrier& bar, const int G, const int lo, const int hi) {

        const int pb = 2 + l * PH_PER_LAYER; const bool moe = (l & 1) != 0; const int jm = l >> 1;
        if (EN_(0) && IN(pb + 0)) { KA a = kargs(); unsigned char* ws = a->ws;
            pg8::Gemm g{(const bf16*)(ws + WS_U), (const bf16*)(ws + WS_WIN) + (size_t)l * NPROJ * D, T, NPROJ, D}; pg8::StaticOrder S; S.init(T, NPROJ, G, (int)blockIdx.x);
            pg8::EpiBf16 E{(bf16*)(ws + WS_PROJ), NPROJ};
            pg8::gemm_phase<pg8::EpiBf16, pg8::StaticOrder, true, true>(lds, g, S, E); SEAM(pb + 0); }
        if (EN_(1) && IN(pb + 1)) { KA a = kargs(); phase_conv(a, l); if (GLA_MFMA) phase_gla_a2(a, l, lds); else phase_gla_a(a, l, lds); SEAM(pb + 1); }
        if (EN_(2) && IN(pb + 2)) { KA a = kargs(); WAVE_IDS; if (GLA_MFMA) phase_scan2(a); else phase_scan(a); if (moe) moe_weights(a, jm, lds, gw, NGW, wave, lane); SEAM(pb + 2); }
        if (EN_(3) && IN(pb + 3)) { KA a = kargs(); if (GLA_MFMA) phase_gla_b2(a, l, lds); else phase_gla_b(a, l, lds); SEAM(pb + 3); }
        if (EN_(4) && IN(pb + 4)) { KA a = kargs(); unsigned char* ws = a->ws;
            pg8::Gemm g{(const bf16*)(ws + WS_Y), (const bf16*)(ws + WS_WOUT) + (size_t)l * D * D, T, D, D}; pg8::StaticOrder S; S.init(T, D, G, (int)blockIdx.x);
            pg8::EpiF32 E{(float*)(ws + WS_MIX), D};
            pg8::gemm_phase<pg8::EpiF32, pg8::StaticOrder, true, true>(lds, g, S, E); SEAM(pb + 4); }
        if (EN_(5) && IN(pb + 5)) { KA a = kargs(); WAVE_IDS; const float* modl = (const float*)(a->ws + WS_MOD) + (size_t)l * 2 * 6144;
            phase_ln<0>(a, l == 0 ? a->in[I_X] : a->out, modl, 2048, a->in[I_LN1G] + (size_t)l * D, a->in[I_LN1B] + (size_t)l * D, 3072, modl, gw, NGW, lane); SEAM(pb + 5); }
        if (moe) {
            if (EN_(6) && IN(pb + 6)) { KA a = kargs(); phase_route1(a, l, lds); SEAM(pb + 6); }
            if (EN_(7) && IN(pb + 7)) { KA a = kargs(); phase_route2(a, lds); SEAM(pb + 7); }
            if (EN_(8) && IN(pb + 8)) { KA a = kargs(); unsigned char* ws = a->ws; const int ntile = *(const int*)(ws + WS_MISC + MS_META);
                pg8::Gemm g{(const bf16*)(ws + WS_XS), (const bf16*)(ws + WS_MWGU), ntile * 256, NGU, D}; pg8::MoeOrder S; S.init(ntile * 256, NGU, G, (int)blockIdx.x); S.tile_e = (const int*)(ws + WS_MISC + MS_TILEE);
                pg8::EpiSwiGLU E{(bf16*)(ws + WS_H), FF};
                pg8::gemm_phase<pg8::EpiSwiGLU, pg8::MoeOrder, true, true>(lds, g, S, E); SEAM(pb + 8); }
            if (EN_(9) && IN(pb + 9)) { KA a = kargs(); unsigned char* ws = a->ws; const int ntile = *(const int*)(ws + WS_MISC + MS_META);
                pg8::Gemm g{(const bf16*)(ws + WS_H), (const bf16*)(ws + WS_MWDN), ntile * 256, D, FF}; pg8::MoeOrder S; S.init(ntile * 256, D, G, (int)blockIdx.x); S.tile_e = (const int*)(ws + WS_MISC + MS_TILEE);
                pg8::EpiMoeDown E{(bf16*)(ws + WS_YS), D, (const int*)(ws + WS_MISC + MS_ROWTOK), (const float*)(ws + WS_MISC + MS_ROWW)};
                pg8::gemm_phase<pg8::EpiMoeDown, pg8::MoeOrder, true, true>(lds, g, S, E); SEAM(pb + 9); }
            if (EN_(10) && IN(pb + 10)) { KA a = kargs(); WAVE_IDS; const float* modl = (const float*)(a->ws + WS_MOD) + (size_t)l * 2 * 6144; const float* modn = (const float*)(a->ws + WS_MOD) + (size_t)(l + 1 < DEPTH ? l + 1 : l) * 2 * 6144;
                phase_ln<1>(a, a->out, modl, 5120, a->in[I_LN2G] + (size_t)l * D, a->in[I_LN2B] + (size_t)l * D, l + 1 < DEPTH ? 0 : -1, modn, gw, NGW, lane); SEAM(pb + 10); }
        } else {
            if (EN_(8) && IN(pb + 8)) { KA a = kargs(); unsigned char* ws = a->ws;
                pg8::Gemm g{(const bf16*)(ws + WS_U), (const bf16*)(ws + WS_WGU) + (size_t)jm * NGU * D, T, NGU, D}; pg8::StaticOrder S; S.init(T, NGU, G, (int)blockIdx.x);
                pg8::EpiSwiGLU E{(bf16*)(ws + WS_H), FF};
                pg8::gemm_phase<pg8::EpiSwiGLU, pg8::StaticOrder, true, true>(lds, g, S, E); SEAM(pb + 8); }
            if (EN_(9) && IN(pb + 9)) { KA a = kargs(); unsigned char* ws = a->ws;
                pg8::Gemm g{(const bf16*)(ws + WS_H), (const bf16*)(ws + WS_WDN) + (size_t)jm * D * FF, T, D, FF}; pg8::StaticOrder S; S.init(T, D, G, (int)blockIdx.x);
                pg8::EpiF32 E{(float*)(ws + WS_MIX), D};
                pg8::gemm_phase<pg8::EpiF32, pg8::StaticOrder, true, true>(lds, g, S, E); SEAM(pb + 9); }
            if (EN_(10) && IN(pb + 10)) { KA a = kargs(); WAVE_IDS; const float* modl = (const float*)(a->ws + WS_MOD) + (size_t)l * 2 * 6144; const float* modn = (const float*)(a->ws + WS_MOD) + (size_t)(l + 1 < DEPTH ? l + 1 : l) * 2 * 6144;
                phase_ln<0>(a, a->out, modl, 5120, a->in[I_LN2G] + (size_t)l * D, a->in[I_LN2B] + (size_t)l * D, l + 1 < DEPTH ? 0 : -1, modn, gw, NGW, lane); SEAM(pb + 10); }
        }
    }
__global__ void __launch_bounds__(NTHR, 2) trunk_fwd(Args args_unused) {
    extern __shared__ __attribute__((aligned(16))) unsigned char lds_raw[];
    LAS unsigned char* lds = (LAS unsigned char*)lds_raw;
    const int G = gridDim.x;
    volatile LAS unsigned* MISC = (volatile LAS unsigned*)(lds + MISC_OFF);
    if (threadIdx.x < 32) MISC[threadIdx.x] = 0u;
    __syncthreads();
    XcdBarrier bar; bar.bar = nullptr; bar.x = 0; bar.st = MISC;
    int lo, hi;
    { KA a = kargs(); lo = a->ph_lo; hi = a->ph_hi; bar.bar = (unsigned*)(a->ws + WS_CTL) + CW_BAR; if (!MK_MULTI) bar = xcd_barrier_post(bar.bar, MISC); }
    if (EN_(11) && IN(0)) { KA a = kargs(); WAVE_IDS; phase_p0(a, lds, gw, NGW, wave, lane); SEAM(0); }
    if (EN_(12) && IN(1)) { KA a = kargs(); WAVE_IDS; phase_p1(a, lds, gw, NGW, lane); SEAM(1); }

    layer_body<0>(lds, bar, G, lo, hi); layer_body<1>(lds, bar, G, lo, hi); layer_body<2>(lds, bar, G, lo, hi); layer_body<3>(lds, bar, G, lo, hi);
#undef IN
#undef SEAM
#undef WAVE_IDS
}

extern "C" void kernel_launch(void* const* d_in, const int* in_sizes, int n_in, void* d_out, int out_size, void* d_ws, size_t ws_size, hipStream_t stream) {
    static int grid = 0;
    if (grid == 0) {
        if (n_in != 21 || in_sizes[0] != T * D || out_size != T * D || ws_size < WS_END) { fprintf(stderr, "kernel_launch: unexpected shapes (n_in %d, in0 %d, out %d, ws %zu < %zu); nothing launched\n", n_in, n_in > 0 ? in_sizes[0] : -1, out_size, ws_size, (size_t)WS_END); grid = -1; return; }
        int dev = 0, cus = 0, per_cu = 0;
        if (hipGetDevice(&dev) != hipSuccess || hipDeviceGetAttribute(&cus, hipDeviceAttributeMultiprocessorCount, dev) != hipSuccess) { grid = -1; return; }
        if (hipFuncSetAttribute((const void*)trunk_fwd, hipFuncAttributeMaxDynamicSharedMemorySize, LDS_BYTES) != hipSuccess) { fprintf(stderr, "kernel_launch: hipFuncSetAttribute failed\n"); grid = -1; return; }
        if (hipOccupancyMaxActiveBlocksPerMultiprocessor(&per_cu, (const void*)trunk_fwd, NTHR, LDS_BYTES) != hipSuccess || per_cu < 1) fprintf(stderr, "kernel_launch: occupancy query reports %d\n", per_cu);
        (void)hipGetLastError();
        grid = cus;
        if (T % grid != 0 || (2 * T / grid) > 512) { fprintf(stderr, "kernel_launch: grid %d unsupported\n", grid); grid = -1; return; }
    }
    if (grid < 0) return;
    if (hipMemsetAsync((char*)d_ws + WS_CTL, 0, CTL_ZERO_BYTES, stream) != hipSuccess) return;
    Args a{};
    for (int i = 0; i < 21; ++i) a.in[i] = (const float*)d_in[i];
    a.out = (float*)d_out; a.ws = (unsigned char*)d_ws; a.li = 0; a.pad = 0;
#if MK_MULTI
    for (int p = 0; p < N_PHASES; ++p) {
        const int r = p - 2, slot = r >= 0 ? r % PH_PER_LAYER : -1, l = r >= 0 ? r / PH_PER_LAYER : 0;
        if (slot >= 0 && (l & 1) == 0 && (slot == 6 || slot == 7)) continue;
        a.ph_lo = p; a.ph_hi = p + 1;
        hipLaunchKernelGGL(trunk_fwd, dim3(grid), dim3(NTHR), LDS_BYTES, stream, a);
    }
#else
    a.ph_lo = 0; a.ph_hi = N_PHASES;
    hipLaunchKernelGGL(trunk_fwd, dim3(grid), dim3(NTHR), LDS_BYTES, stream, a);
#endif
    const hipError_t le = hipPeekAtLastError();
    if (le != hipSuccess) fprintf(stderr, "kernel_launch: launch failed: %s\n", hipGetErrorName(le));
}
```
